# Optimizing an MI355X kernel written in HIP

```python
import math
import jax, jax.numpy as jnp
from jax import lax
import numpy as np

D_MODEL = 1024
BATCH = 8
SEQ = 8192
DEPTH = 1

D_HYENA = 768
D_LRU = 768
D_MIX = D_HYENA + D_LRU
N_HYENA_GROUPS = 12
N_LRU_HEADS = 12
LRU_HEAD_DIM = D_LRU // N_LRU_HEADS
D_IN = 4 * D_HYENA + 2 * D_LRU
HYENA_SHORT_CONV = 3
LRU_CONV = 4
FILTER_EMB_DIM = 33
FILTER_BANDS = (FILTER_EMB_DIM - 1) // 2
FILTER_HIDDEN = 64
FILTER_TARGET = 1e-2
FAST_DECAY_PCT = 0.3
SLOW_DECAY_PCT = 1.5
MIN_DECAY = math.log(FILTER_TARGET) / FAST_DECAY_PCT
MAX_DECAY = math.log(FILTER_TARGET) / SLOW_DECAY_PCT
LRU_C = 8.0
EPS = 1e-6

kernel_name = "hymba_hyena_rglru_bidir_block"


def _rmsnorm(x, g):
    xf = x.astype(jnp.float32)
    y = xf * lax.rsqrt(jnp.mean(xf * xf, axis=-1, keepdims=True) + EPS)
    return (y * g.astype(jnp.float32)).astype(x.dtype)


def _dwconv(u, w, b, pad_lo, pad_hi):
    L = u.shape[1]
    up = jnp.pad(u, ((0, 0), (pad_lo, pad_hi), (0, 0)))
    y = b
    for k in range(w.shape[0]):
        y = y + up[:, k:k + L, :] * w[k]
    return y


def _hyena_filter(L, w1, b1, f1, w2, b2, f2, w3, b3, f3, w4):
    f32 = jnp.float32
    t = jnp.linspace(0.0, 1.0, L, dtype=f32)[:, None]
    w = (2.0 * math.pi / L) * jnp.arange(L, dtype=f32)[:, None]
    f = jnp.linspace(1e-4, FILTER_BANDS - 1, FILTER_BANDS, dtype=f32)[None, :]
    z = jnp.concatenate([t, jnp.cos(w * f), -jnp.sin(w * f)], axis=-1)
    h = jnp.sin(f1.astype(f32) * (z @ w1.astype(f32) + b1.astype(f32)))
    h = jnp.sin(f2.astype(f32) * (h @ w2.astype(f32) + b2.astype(f32)))
    h = jnp.sin(f3.astype(f32) * (h @ w3.astype(f32) + b3.astype(f32)))
    h = h @ w4.astype(f32)
    deltas = jnp.linspace(MIN_DECAY, MAX_DECAY, D_HYENA, dtype=f32)
    window = jnp.exp(-t * jnp.abs(deltas)[None, :])
    h_fwd = h[:, :D_HYENA] * window
    h_bwd = h[:, D_HYENA:] * window
    k = jnp.concatenate([h_fwd, jnp.zeros((1, D_HYENA), f32), h_bwd[:0:-1]], axis=0)
    return k / (jnp.sum(jnp.abs(k), axis=0, keepdims=True) + EPS)


def _fft_conv(u, k):
    L = u.shape[1]
    U = jnp.fft.rfft(u, n=2 * L, axis=1)
    K = jnp.fft.rfft(k, n=2 * L, axis=0)
    return jnp.fft.irfft(U * K[None], n=2 * L, axis=1)[:, :L]


def _lin_comb(c1, c2):
    a1, b1 = c1
    a2, b2 = c2
    return a1 * a2, a2 * b1 + b2


def _rglru_dir(xb, wa, ba, wx, bx, lam):
    B, L, _ = xb.shape
    xh = xb.reshape(B, L, N_LRU_HEADS, LRU_HEAD_DIM)
    r = jax.nn.sigmoid(jnp.einsum('blhi,hij->blhj', xh, wa).reshape(B, L, D_LRU) + ba)
    i = jax.nn.sigmoid(jnp.einsum('blhi,hij->blhj', xh, wx).reshape(B, L, D_LRU) + bx)
    log_a = -LRU_C * r * jax.nn.softplus(-lam)
    a = jnp.exp(log_a)
    mult = jnp.sqrt(-jnp.expm1(2.0 * log_a))
    mult = mult.at[:, 0].set(1.0)
    _, h = lax.associative_scan(_lin_comb, (a, mult * (i * xb)), axis=1)
    return h


def setup_inputs(seed: int = 0) -> dict:
    key = jax.random.key(seed)
    ks = iter(jax.random.split(key, 40))
    f32 = jnp.float32

    def nrm(shape, scale):
        return jax.random.normal(next(ks), shape, f32) * scale

    x = jax.random.normal(next(ks), (BATCH, SEQ, D_MODEL), f32)
    a_c = jax.random.uniform(next(ks), (DEPTH, 2, D_LRU), f32, 0.9, 0.999)
    a_base = a_c ** (1.0 / LRU_C)
    lru_lam = jnp.log(a_base) - jnp.log1p(-a_base)
    return {
        "x": x,
        "norm_g": 1.0 + nrm((DEPTH, D_MODEL), 0.02),
        "w_in": nrm((DEPTH, D_MODEL, D_IN), D_MODEL ** -0.5),
        "hy_conv_w": nrm((DEPTH, HYENA_SHORT_CONV, 3 * D_HYENA), HYENA_SHORT_CONV ** -0.5),
        "hy_conv_b": nrm((DEPTH, 3 * D_HYENA), 0.02),
        "flt_w1": nrm((DEPTH, FILTER_EMB_DIM, FILTER_HIDDEN), FILTER_EMB_DIM ** -0.5),
        "flt_b1": nrm((DEPTH, FILTER_HIDDEN), 0.02),
        "flt_f1": 1.0 + nrm((DEPTH, FILTER_HIDDEN), 0.02),
        "flt_w2": nrm((DEPTH, FILTER_HIDDEN, FILTER_HIDDEN), FILTER_HIDDEN ** -0.5),
        "flt_b2": nrm((DEPTH, FILTER_HIDDEN), 0.02),
        "flt_f2": 1.0 + nrm((DEPTH, FILTER_HIDDEN), 0.02),
        "flt_w3": nrm((DEPTH, FILTER_HIDDEN, FILTER_HIDDEN), FILTER_HIDDEN ** -0.5),
        "flt_b3": nrm((DEPTH, FILTER_HIDDEN), 0.02),
        "flt_f3": 1.0 + nrm((DEPTH, FILTER_HIDDEN), 0.02),
        "flt_w4": nrm((DEPTH, FILTER_HIDDEN, 2 * D_HYENA), FILTER_HIDDEN ** -0.5),
        "hy_skip": nrm((DEPTH, D_HYENA), 0.5),
        "lru_conv_w": nrm((DEPTH, LRU_CONV, D_LRU), LRU_CONV ** -0.5),
        "lru_conv_b": nrm((DEPTH, D_LRU), 0.02),
        "lru_wa": nrm((DEPTH, 2, N_LRU_HEADS, LRU_HEAD_DIM, LRU_HEAD_DIM), LRU_HEAD_DIM ** -0.5),
        "lru_ba": nrm((DEPTH, 2, D_LRU), 0.02),
        "lru_wx": nrm((DEPTH, 2, N_LRU_HEADS, LRU_HEAD_DIM, LRU_HEAD_DIM), LRU_HEAD_DIM ** -0.5),
        "lru_bx": nrm((DEPTH, 2, D_LRU), 0.02),
        "lru_lam": lru_lam,
        "hy_out_g": 1.0 + nrm((DEPTH, D_HYENA), 0.02),
        "lru_out_g": 1.0 + nrm((DEPTH, D_LRU), 0.02),
        "w_out": nrm((DEPTH, D_MIX, D_MODEL), D_MIX ** -0.5),
        "final_g": 1.0 + nrm((D_MODEL,), 0.02),
    }


def reference(x, norm_g, w_in, hy_conv_w, hy_conv_b, flt_w1, flt_b1, flt_f1,
              flt_w2, flt_b2, flt_f2, flt_w3, flt_b3, flt_f3, flt_w4, hy_skip,
              lru_conv_w, lru_conv_b, lru_wa, lru_ba, lru_wx, lru_bx, lru_lam,
              hy_out_g, lru_out_g, w_out, final_g):
    f32 = jnp.float32
    L = x.shape[1]
    for l in range(DEPTH):
        xn = _rmsnorm(x, norm_g[l])
        proj = jnp.einsum('bld,de->ble', xn, w_in[l]).astype(f32)
        o = 0
        hy_in = proj[..., o:o + 3 * D_HYENA]; o += 3 * D_HYENA
        hy_gate = proj[..., o:o + D_HYENA]; o += D_HYENA
        lru_in = proj[..., o:o + D_LRU]; o += D_LRU
        lru_gate = proj[..., o:o + D_LRU]

        hy = _dwconv(hy_in, hy_conv_w[l].astype(f32), hy_conv_b[l].astype(f32), 1, 1)
        v = hy[..., :D_HYENA]
        x0 = hy[..., D_HYENA:2 * D_HYENA]
        x1 = hy[..., 2 * D_HYENA:]
        kfilt = _hyena_filter(L, flt_w1[l], flt_b1[l], flt_f1[l], flt_w2[l], flt_b2[l],
                              flt_f2[l], flt_w3[l], flt_b3[l], flt_f3[l], flt_w4[l])
        u = v * x1
        y_hy = x0 * (_fft_conv(u, kfilt) + hy_skip[l].astype(f32) * u)

        xb = _dwconv(lru_in, lru_conv_w[l].astype(f32), lru_conv_b[l].astype(f32), 1, 2)
        h_f = _rglru_dir(xb, lru_wa[l, 0].astype(f32), lru_ba[l, 0].astype(f32),
                         lru_wx[l, 0].astype(f32), lru_bx[l, 0].astype(f32),
                         lru_lam[l, 0].astype(f32))
        h_b = _rglru_dir(xb[:, ::-1], lru_wa[l, 1].astype(f32), lru_ba[l, 1].astype(f32),
                         lru_wx[l, 1].astype(f32), lru_bx[l, 1].astype(f32),
                         lru_lam[l, 1].astype(f32))[:, ::-1]
        y_lru = h_f + h_b

        y_cat = jnp.concatenate([
            _rmsnorm(y_hy, hy_out_g[l]) * jax.nn.silu(hy_gate),
            _rmsnorm(y_lru, lru_out_g[l]) * jax.nn.silu(lru_gate)], axis=-1)
        y = jnp.einsum('ble,ed->bld', y_cat.astype(x.dtype), w_out[l])
        x = x + y.astype(x.dtype)
    return _rmsnorm(x, final_g)
```

```cpp
#include <hip/hip_runtime.h>
#include <hip/hip_cooperative_groups.h>
#include <cstdio>
namespace cg = cooperative_groups;
#ifndef MK_N_LAUNCHES
#define MK_N_LAUNCHES 1
#endif
namespace pg8 {
#define PG8_LAS __attribute__((address_space(3)))
typedef unsigned short bf16_t;
typedef short bf16x8 __attribute__((ext_vector_type(8)));
typedef float f32x4 __attribute__((ext_vector_type(4)));
typedef unsigned u32x4 __attribute__((ext_vector_type(4)));
constexpr int BM = 256, BK = 64, HALF = 128, HTB = HALF * BK * 2  , STAGE_BYTES = 8 * HTB, NXCD = 8, WGM = 8;

__host__ __device__ __forceinline__ int lds_byte(int r, int c) { const int st = (r >> 4) * 2 + (c >> 5), rr = r & 15, cc = c & 31, ob = rr * 64 + cc * 2; return st * 1024 + (ob ^ (((ob >> 9) & 1) << 5)); }
__host__ __device__ __forceinline__ void stage_rc(int b, int& R, int& C) { const int st = b / 1024, sb = b % 1024, swz = sb ^ (((sb >> 9) & 1) << 5); R = (st >> 1) * 16 + swz / 64; C = (st & 1) * 32 + (swz % 64) / 2; }
__host__ __device__ __forceinline__ int perm32(int rho) { const int n = rho >> 4, i = rho & 15; return 8 * (i >> 2) + 4 * n + (i & 3); }

struct Unit { int pm, pn; };
struct Gemm { const bf16_t* A; const bf16_t* Bt; int M, N, K; };

struct StaticOrder {
    int nM, nN, nwg, G, c;
    __host__ __device__ void init(int M, int N, int G_, int c_) { nM = M / BM; nN = N / BM; nwg = nM * nN; G = G_; c = c_; }
    __host__ __device__ bool next(int i, Unit& u) const {
        const long L = (long)i * G + c; if (L >= nwg) return false;
        int wgid = (int)L; { const int q = nwg / NXCD, r = nwg % NXCD, xcd = wgid % NXCD, off = wgid / NXCD; wgid = (xcd < r ? xcd * (q + 1) : r * (q + 1) + (xcd - r) * q) + off; }
        const int nig = WGM * nN, gid = wgid / nig, fm = gid * WGM, gsz = (nM - fm) < WGM ? (nM - fm) : WGM;
        u.pm = fm + ((wgid % nig) % gsz); u.pn = (wgid % nig) / gsz; return true;
    }
    __device__ __forceinline__ void a_ready(const Unit&) const {}
    __device__ __forceinline__ void done(const Unit&) const {}
};
__device__ __forceinline__ unsigned cvt_pk_bf16(float lo, float hi) { unsigned r; asm volatile("v_cvt_pk_bf16_f32 %0, %1, %2" : "=v"(r) : "v"(lo), "v"(hi)); return r; }
typedef float f32x2 __attribute__((ext_vector_type(2)));

struct EpiStoreBf16 {
    static constexpr bool PERM = true, AFTER_DRAIN = false;
    bf16_t* O; int ldc;
    __device__ __forceinline__ void operator()(const f32x4 (&acc)[2][2][4][2], const Unit& u, int wr, int wc, int fr, int fq) const {
        const int row0 = u.pm * BM + wr * 64 + fr; const int col0 = u.pn * BM + wc * 32 + 8 * fq;
#pragma unroll
        for (int ai = 0; ai < 2; ++ai)
#pragma unroll
            for (int m = 0; m < 4; ++m) { bf16_t* rowp = O + (size_t)(row0 + ai * HALF + m * 16) * ldc + col0;
#pragma unroll
                for (int bj = 0; bj < 2; ++bj) { const f32x4 v0 = acc[ai][bj][m][0], v1 = acc[ai][bj][m][1];
                    u32x4 w; w.x = cvt_pk_bf16(v0[0], v0[1]); w.y = cvt_pk_bf16(v0[2], v0[3]); w.z = cvt_pk_bf16(v1[0], v1[1]); w.w = cvt_pk_bf16(v1[2], v1[3]);
                    *(u32x4*)(rowp + bj * HALF) = w; } }
    }
};
struct EpiResidF32 {
    static constexpr bool PERM = false, AFTER_DRAIN = false;
    float* C; const float* X; int ldc;
    __device__ __forceinline__ void operator()(const f32x4 (&acc)[2][2][4][2], const Unit& u, int wr, int wc, int fr, int fq) const {
        const int row0 = u.pm * BM + wr * 64 + fr, col0 = u.pn * BM + wc * 32 + 4 * fq;
#pragma unroll
        for (int ai = 0; ai < 2; ++ai)
#pragma unroll
            for (int m = 0; m < 4; ++m) { const size_t off = (size_t)(row0 + ai * HALF + m * 16) * ldc + col0;
#pragma unroll
                for (int bj = 0; bj < 2; ++bj)
#pragma unroll
                    for (int n = 0; n < 2; ++n) { const f32x4 xv = *(const f32x4*)(X + off + bj * HALF + n * 16); *(f32x4*)(C + off + bj * HALF + n * 16) = acc[ai][bj][m][n] + xv; } }
    }
};
template <class Epi, class Sched, bool STAMP = false>
__device__ __forceinline__ void gemm_phase(PG8_LAS unsigned char* lds, const Gemm g, const Sched& S, const Epi& E, unsigned long long* stamps) {
    const int tid = threadIdx.x, wid = __builtin_amdgcn_readfirstlane(tid >> 6), lane = tid & 63, wr = wid >> 2, wc = wid & 3, fr = lane & 15, fq = lane >> 4;
    const int K = g.K, nt = K / BK;
    int ts_lo = 0, ts_hi = 0, nts = 0; const unsigned long long rt_entry = STAMP ? (unsigned long long)wall_clock64() : 0ull;
#define PG8_STAMP() do { if (STAMP && wid == 0 && nts < 64) { const unsigned long long _c = (unsigned long long)clock64(); \
        ts_lo = (lane == nts) ? (int)(unsigned)_c : ts_lo; ts_hi = (lane == nts) ? (int)(unsigned)(_c >> 32) : ts_hi; ++nts; } } while (0)
    PG8_STAMP();
    unsigned voffA[2], voffB[2];
#pragma unroll
    for (int i = 0; i < 2; ++i) { int R, C; stage_rc(tid * 16 + i * 8192, R, C); const int Rb = Epi::PERM ? ((R & ~31) + perm32(R & 31)) : R;
        voffA[i] = (unsigned)(R * K + C) * 2u; voffB[i] = (unsigned)(Rb * K + C) * 2u; }
    const size_t kstep = (size_t)(BK * 2);
    const size_t hstep = (size_t)HALF * K * 2;
    const size_t tstep = 2 * hstep;
    const unsigned ldsw = (unsigned)wid * 1024u;
    const int aoff = lds_byte(wr * 64 + fr, fq * 8), boff = lds_byte(wc * 32 + fr, fq * 8);
#define PG8_SA(b, h) (((b) * 2 + (h)) * HTB)
#define PG8_SB(b, h) ((4 + (b) * 2 + (h)) * HTB)
#define PG8_STAGE(bufoff, gbase, voff) do { _Pragma("unroll") for (int _i = 0; _i < 2; ++_i) \
        __builtin_amdgcn_global_load_lds((const unsigned*)((const char*)(gbase) + (voff)[_i]), (PG8_LAS unsigned*)(lds + (bufoff) + ldsw + _i * 8192), 16, 0, 0); } while (0)
#define PG8_LDA(dst, b, h) do { _Pragma("unroll") for (int m = 0; m < 4; ++m) _Pragma("unroll") for (int k = 0; k < 2; ++k) dst[m][k] = *(const PG8_LAS bf16x8*)(lds + PG8_SA(b, h) + aoff + m * 2048 + k * 1024); } while (0)
#define PG8_LDB(dst, b, h) do { _Pragma("unroll") for (int n = 0; n < 2; ++n) _Pragma("unroll") for (int k = 0; k < 2; ++k) dst[n][k] = *(const PG8_LAS bf16x8*)(lds + PG8_SB(b, h) + boff + n * 2048 + k * 1024); } while (0)
#define PG8_MMA(ai, bj, At, Bt) do { __builtin_amdgcn_s_setprio(1); _Pragma("unroll") for (int m = 0; m < 4; ++m) _Pragma("unroll") for (int n = 0; n < 2; ++n) _Pragma("unroll") for (int k = 0; k < 2; ++k) \
        acc[ai][bj][m][n] = __builtin_amdgcn_mfma_f32_16x16x32_bf16(Bt[n][k], At[m][k], acc[ai][bj][m][n], 0, 0, 0); __builtin_amdgcn_s_setprio(0); } while (0)
#define PG8_WAIT_V(n) asm volatile("s_waitcnt vmcnt(" #n ")" ::: "memory")
#define PG8_WAIT_L(n) asm volatile("s_waitcnt lgkmcnt(" #n ")" ::: "memory")
#define PG8_BAR __builtin_amdgcn_s_barrier()
#define PG8_SCHED __builtin_amdgcn_sched_barrier(0)
    Unit cur, nxt; int ui = 0;
    if (!S.next(0, cur)) return;
    f32x4 acc[2][2][4][2];
#pragma unroll
    for (int a = 0; a < 2; ++a)
#pragma unroll
        for (int b = 0; b < 2; ++b)
#pragma unroll
            for (int m = 0; m < 4; ++m)
#pragma unroll
                for (int n = 0; n < 2; ++n) acc[a][b][m][n] = (f32x4){0.f, 0.f, 0.f, 0.f};
    bf16x8 At[4][2], B0[2][2], B1[2][2];
    const char* cA = (const char*)g.A + (size_t)cur.pm * tstep; const char* cB = (const char*)g.Bt + (size_t)cur.pn * tstep;
    S.a_ready(cur);
    PG8_STAGE(PG8_SB(0, 0), cB, voffB); PG8_STAGE(PG8_SA(0, 0), cA, voffA); PG8_STAGE(PG8_SB(0, 1), cB + hstep, voffB); PG8_STAGE(PG8_SA(0, 1), cA + hstep, voffA);
    if (wr == 1) PG8_BAR;
    PG8_WAIT_V(4); PG8_BAR;
    PG8_STAGE(PG8_SB(1, 0), cB + kstep, voffB); PG8_STAGE(PG8_SA(1, 0), cA + kstep, voffA); PG8_STAGE(PG8_SB(1, 1), cB + hstep + kstep, voffB);
    PG8_WAIT_V(6); PG8_BAR;
    PG8_STAMP();
    for (;;) {
        const bool has_next = S.next(ui + 1, nxt);
        const char* nA = has_next ? (const char*)g.A + (size_t)nxt.pm * tstep : cA; const char* nB = has_next ? (const char*)g.Bt + (size_t)nxt.pn * tstep : cB;
        for (int t = 0; t < nt; t += 2) {
            const bool last = (t == nt - 2);
            const char* a1 = cA + (size_t)(t + 1) * kstep;
            const char* a2 = last ? nA : cA + (size_t)(t + 2) * kstep; const char* b2 = last ? nB : cB + (size_t)(t + 2) * kstep;
            const char* a3 = a2 + kstep; const char* b3 = b2 + kstep;
            if (last && has_next) S.a_ready(nxt);
            PG8_LDB(B0, 0, 0); PG8_SCHED; PG8_LDA(At, 0, 0); PG8_STAGE(PG8_SA(1, 1), a1 + hstep, voffA);
            PG8_WAIT_L(8); PG8_BAR; PG8_WAIT_L(0); PG8_MMA(0, 0, At, B0); PG8_BAR; PG8_SCHED;
            PG8_LDB(B1, 0, 1); PG8_STAGE(PG8_SB(0, 0), b2, voffB);
            PG8_BAR; PG8_WAIT_L(0); PG8_MMA(0, 1, At, B1); PG8_BAR;
            PG8_LDA(At, 0, 1); PG8_STAGE(PG8_SA(0, 0), a2, voffA);
            PG8_BAR; PG8_WAIT_L(0); PG8_MMA(1, 0, At, B0); PG8_BAR; PG8_SCHED;
            PG8_STAGE(PG8_SB(0, 1), b2 + hstep, voffB);
            PG8_WAIT_V(6); PG8_BAR; PG8_MMA(1, 1, At, B1); PG8_BAR;
            PG8_LDB(B0, 1, 0); PG8_SCHED; PG8_LDA(At, 1, 0); PG8_STAGE(PG8_SA(0, 1), a2 + hstep, voffA);
            PG8_WAIT_L(8); PG8_BAR; PG8_WAIT_L(0); PG8_MMA(0, 0, At, B0); PG8_BAR; PG8_SCHED;
            PG8_LDB(B1, 1, 1); PG8_STAGE(PG8_SB(1, 0), b3, voffB);
            PG8_BAR; PG8_WAIT_L(0); PG8_MMA(0, 1, At, B1); PG8_BAR;
            PG8_LDA(At, 1, 1); PG8_STAGE(PG8_SA(1, 0), a3, voffA);
            PG8_BAR; PG8_WAIT_L(0); PG8_MMA(1, 0, At, B0); PG8_BAR; PG8_SCHED;
            PG8_STAGE(PG8_SB(1, 1), b3 + hstep, voffB);
            PG8_WAIT_V(6); PG8_BAR; PG8_MMA(1, 1, At, B1); PG8_BAR;
        }
        PG8_STAMP();
        if constexpr (!Epi::AFTER_DRAIN) { E(acc, cur, wr, wc, fr, fq); S.done(cur); }
        PG8_STAMP();
        if (!has_next) break;
#pragma unroll
        for (int a = 0; a < 2; ++a)
#pragma unroll
            for (int b = 0; b < 2; ++b)
#pragma unroll
                for (int m = 0; m < 4; ++m)
#pragma unroll
                    for (int n = 0; n < 2; ++n) acc[a][b][m][n] = (f32x4){0.f, 0.f, 0.f, 0.f};
        cur = nxt; cA = nA; cB = nB; ++ui;
    }
    PG8_WAIT_V(0);
    if (wr == 0) PG8_BAR;
    PG8_BAR;
    if constexpr (Epi::AFTER_DRAIN) { E.fused(acc, cur, wr, wc, fr, fq, lds, wid, lane); S.done(cur); }
    PG8_STAMP();
    if (STAMP && wid == 0) { stamps[lane] = lane < nts ? (((unsigned long long)(unsigned)ts_hi << 32) | (unsigned)ts_lo) : 0ull;
        if (lane == 62) stamps[62] = rt_entry; if (lane == 63) stamps[63] = (unsigned long long)wall_clock64(); }
#undef PG8_STAMP
#undef PG8_SA
#undef PG8_SB
#undef PG8_STAGE
#undef PG8_LDA
#undef PG8_LDB
#undef PG8_MMA
#undef PG8_WAIT_V
#undef PG8_WAIT_L
#undef PG8_BAR
#undef PG8_SCHED
}
}

using pg8::bf16_t;
typedef short bf16x8_t __attribute__((ext_vector_type(8)));
typedef float f32x4_t __attribute__((ext_vector_type(4)));

constexpr int NB = 8, SEQ = 8192, DM = 1024, DH = 768, NTOK = NB * SEQ;
constexpr size_t MiB = 1ull << 20;
constexpr size_t OFF_XN = 0, OFF_YHT = 0, OFF_HYT = 128 * MiB, OFF_YCAT = 128 * MiB, OFF_P2 = 416 * MiB, OFF_KF = 704 * MiB, OFF_KH = 752 * MiB,
                 OFF_HF = 784 * MiB, OFF_HB = 880 * MiB, OFF_WT1 = 976 * MiB, OFF_WT2 = 985 * MiB, OFF_PS = 988 * MiB, OFF_CTL = 990 * MiB, WS_END = 991 * MiB;
constexpr int NFFT = 16384;
constexpr int ZPHYS = NFFT + (NFFT / 64) * 4;
constexpr int LDS_BYTES = ZPHYS * 8 + 256;
constexpr int N_LRU_UNITS = 192, N_HY_UNITS = 768;
#ifndef MIX_SEL
#define MIX_SEL 0
#endif

struct Params { const float* in[27]; float* out; unsigned char* ws; int ph_lo, ph_hi; };

__device__ __forceinline__ float bf2f(unsigned short b) { return __uint_as_float(((unsigned)b) << 16); }
__device__ __forceinline__ float bflo(unsigned w) { return __uint_as_float(w << 16); }
__device__ __forceinline__ float bfhi(unsigned w) { return __uint_as_float(w & 0xffff0000u); }
__device__ __forceinline__ unsigned pk(float a, float b) { return pg8::cvt_pk_bf16(a, b); }
__device__ __forceinline__ float wave_sum(float v) {
#pragma unroll
    for (int o = 32; o; o >>= 1) v += __shfl_xor(v, o);
    return v; }
__device__ __forceinline__ float sigm(float x) { return __builtin_amdgcn_rcpf(1.0f + __expf(-x)); }
__device__ __forceinline__ float sin_rad(float x) { const float r = x * 0.15915494309189535f; return __builtin_amdgcn_sinf(r - floorf(r)); }
__device__ __forceinline__ float cos_rad(float x) { const float r = x * 0.15915494309189535f; return __builtin_amdgcn_cosf(r - floorf(r)); }

__device__ void phase_xn(const Params& p) {
    const int tid = threadIdx.x, lane = tid & 63, wid = tid >> 6;
    const float* x = p.in[0]; bf16_t* XN = (bf16_t*)(p.ws + OFF_XN);
    for (int row = blockIdx.x * 8 + wid; row < NTOK; row += gridDim.x * 8) {
        const float4* src = (const float4*)(x + (size_t)row * DM);
        float4 v[4]; float ss = 0.f;
#pragma unroll
        for (int i = 0; i < 4; ++i) { v[i] = src[i * 64 + lane]; ss += v[i].x * v[i].x + v[i].y * v[i].y + v[i].z * v[i].z + v[i].w * v[i].w; }
        ss = wave_sum(ss);
        const float rs = rsqrtf(ss * (1.0f / DM) + 1e-6f);
        uint2* dst = (uint2*)(XN + (size_t)row * DM);
#pragma unroll
        for (int i = 0; i < 4; ++i) { uint2 w; w.x = pk(v[i].x * rs, v[i].y * rs); w.y = pk(v[i].z * rs, v[i].w * rs); dst[i * 64 + lane] = w; }
    }
}
__device__ void transpose_to_bf16(const float* src, int R, int C, const float* rowscale, bf16_t* dst, float* tile) {
    const int tid = threadIdx.x; const int tc = C / 64, nt = (R / 64) * tc;
    for (int t = blockIdx.x; t < nt; t += gridDim.x) {
        const int r0 = (t / tc) * 64, c0 = (t % tc) * 64;
        __syncthreads();
#pragma unroll
        for (int i = 0; i < 2; ++i) { const int r = (tid >> 4) + 32 * i, c4 = (tid & 15) * 4;
            const float4 v = *(const float4*)(src + (size_t)(r0 + r) * C + c0 + c4); const float s = rowscale ? rowscale[r0 + r] : 1.0f;
            tile[r * 65 + c4 + 0] = v.x * s; tile[r * 65 + c4 + 1] = v.y * s; tile[r * 65 + c4 + 2] = v.z * s; tile[r * 65 + c4 + 3] = v.w * s; }
        __syncthreads();
        { const int c = tid >> 3, r8 = (tid & 7) * 8; float v[8];
#pragma unroll
          for (int e = 0; e < 8; ++e) v[e] = tile[(r8 + e) * 65 + c];
          uint4 w; w.x = pk(v[0], v[1]); w.y = pk(v[2], v[3]); w.z = pk(v[4], v[5]); w.w = pk(v[6], v[7]);
          *(uint4*)(dst + (size_t)(c0 + c) * R + r0 + r8) = w; }
    }
}
__device__ void phase_filter(const Params& p, unsigned char* lds) {
    const int tid = threadIdx.x;
    float* Z = (float*)lds; float* H1 = Z + 32 * 33; float* H2 = H1 + 2048; float* H3 = H2 + 2048;
    const float *w1 = p.in[5], *b1 = p.in[6], *f1 = p.in[7], *w2 = p.in[8], *b2 = p.in[9], *f2 = p.in[10], *w3 = p.in[11], *b3 = p.in[12], *f3 = p.in[13], *w4 = p.in[14];
    float* KF = (float*)(p.ws + OFF_KF); float* PS = (float*)(p.ws + OFF_PS);
    const float MIN_DECAY = -15.350567286626973f, MAX_DECAY = -3.0701134573253945f;
    for (int item = blockIdx.x; item < 256; item += gridDim.x) {
        const int j0 = item * 32;
        __syncthreads();
        for (int idx = tid; idx < 32 * 33; idx += 512) { const int row = idx / 33, i = idx % 33, j = j0 + row; float val;
            if (i == 0) val = (float)j * (1.0f / 8191.0f);
            else { const int m = (i - 1) & 15; const float fm = 1e-4f + (float)m * ((15.0f - 1e-4f) / 15.0f); const float wj = (float)j * (6.283185307179586f / 8192.0f); const float xx = wj * fm;
                val = (i <= 16) ? cos_rad(xx) : -sin_rad(xx); }
            Z[idx] = val; }
        __syncthreads();
        for (int idx = tid; idx < 2048; idx += 512) { const int row = idx >> 6, o = idx & 63; float acc = b1[o];
            for (int i = 0; i < 33; ++i) acc += Z[row * 33 + i] * w1[i * 64 + o];
            H1[idx] = sin_rad(f1[o] * acc); }
        __syncthreads();
        for (int idx = tid; idx < 2048; idx += 512) { const int row = idx >> 6, o = idx & 63; float acc = b2[o];
            for (int i = 0; i < 64; ++i) acc += H1[row * 64 + i] * w2[i * 64 + o];
            H2[idx] = sin_rad(f2[o] * acc); }
        __syncthreads();
        for (int idx = tid; idx < 2048; idx += 512) { const int row = idx >> 6, o = idx & 63; float acc = b3[o];
            for (int i = 0; i < 64; ++i) acc += H2[row * 64 + i] * w3[i * 64 + o];
            H3[idx] = sin_rad(f3[o] * acc); }
        __syncthreads();
#pragma unroll 1
        for (int pp = 0; pp < 3; ++pp) {
            const int cp = tid + 512 * pp; float acc[32];
#pragma unroll
            for (int r = 0; r < 32; ++r) acc[r] = 0.f;
            for (int i = 0; i < 64; ++i) { const float w = w4[i * 1536 + cp];
#pragma unroll
                for (int r = 0; r < 32; ++r) acc[r] += H3[r * 64 + i] * w; }
            const bool bwd = cp >= DH; const int c = bwd ? cp - DH : cp;
            const float ad = fabsf(MIN_DECAY + (float)c * ((MAX_DECAY - MIN_DECAY) / 767.0f));
            float asum = 0.f; float* kc = KF + (size_t)c * NFFT;
#pragma unroll
            for (int r = 0; r < 32; ++r) { const int j = j0 + r; const float tj = (float)j * (1.0f / 8191.0f); const float val = acc[r] * __expf(-tj * ad);
                if (!bwd) { kc[j] = val; asum += fabsf(val); } else if (j >= 1) { kc[NFFT - j] = val; asum += fabsf(val); } }
            PS[item * 1536 + cp] = asum;
            if (item == 0 && !bwd) kc[SEQ] = 0.f;
        }
    }
}
__device__ void phase0(const Params& p, unsigned char* lds) {
    phase_xn(p);
    transpose_to_bf16(p.in[2], DM, 4608, p.in[1], (bf16_t*)(p.ws + OFF_WT1), (float*)lds);
    transpose_to_bf16(p.in[25], 1536, DM, nullptr, (bf16_t*)(p.ws + OFF_WT2), (float*)lds);
    phase_filter(p, lds);
}
__device__ void phase_gemm1(const Params& p, unsigned char* lds) {
    PG8_LAS unsigned char* l3 = (PG8_LAS unsigned char*)lds;
    const bf16_t* XN = (const bf16_t*)(p.ws + OFF_XN); const bf16_t* WT1 = (const bf16_t*)(p.ws + OFF_WT1);
#pragma unroll 1
    for (int pass = 0; pass < 2; ++pass) {
        int ps = pass; asm volatile("" : "+s"(ps));
        pg8::StaticOrder S; pg8::Gemm g; pg8::EpiStoreBf16 E;
        g.A = ps ? XN : WT1; g.Bt = ps ? WT1 + (size_t)2304 * DM : XN; g.M = ps ? NTOK : 2304; g.N = ps ? 2304 : NTOK; g.K = DM;
        E.O = (bf16_t*)(p.ws + (ps ? OFF_P2 : OFF_HYT)); E.ldc = g.N;
        S.init(g.M, g.N, (int)gridDim.x, (int)blockIdx.x);
        pg8::gemm_phase<pg8::EpiStoreBf16, pg8::StaticOrder, false>(l3, g, S, E, nullptr);
        __syncthreads();
    }
}
__device__ void phase_gemm2(const Params& p, unsigned char* lds) {
    PG8_LAS unsigned char* l3 = (PG8_LAS unsigned char*)lds;
    pg8::StaticOrder S; pg8::Gemm g{(const bf16_t*)(p.ws + OFF_YCAT), (const bf16_t*)(p.ws + OFF_WT2), NTOK, DM, 1536}; S.init(NTOK, DM, (int)gridDim.x, (int)blockIdx.x);
    pg8::EpiResidF32 E{p.out, p.in[0], DM};
    pg8::gemm_phase<pg8::EpiResidF32, pg8::StaticOrder, false>(l3, g, S, E, nullptr);
}
__device__ __forceinline__ int phys(int e) { return e + ((e >> 6) << 2); }
__device__ __forceinline__ float2 cmul(float2 a, float2 b) { return make_float2(a.x * b.x - a.y * b.y, a.x * b.y + a.y * b.x); }
__device__ __forceinline__ constexpr float c16(int k) { return k == 0 ? 1.0f : k == 1 ? 0.9238795325112867f : k == 2 ? 0.7071067811865476f : k == 3 ? 0.3826834323650898f : k == 4 ? 0.0f : k == 6 ? -0.7071067811865476f : k == 9 ? -0.9238795325112867f : 0.0f; }
__device__ __forceinline__ constexpr float s16(int k) { return k == 0 ? 0.0f : k == 1 ? 0.3826834323650898f : k == 2 ? 0.7071067811865476f : k == 3 ? 0.9238795325112867f : k == 4 ? 1.0f : k == 6 ? 0.7071067811865476f : k == 9 ? -0.3826834323650898f : 0.0f; }
template <int SGN> __device__ __forceinline__ void bfly4(float2& a0, float2& a1, float2& a2, float2& a3) {
    const float2 t0 = make_float2(a0.x + a2.x, a0.y + a2.y), t1 = make_float2(a0.x - a2.x, a0.y - a2.y), t2 = make_float2(a1.x + a3.x, a1.y + a3.y), t3 = make_float2(a1.x - a3.x, a1.y - a3.y);
    const float2 r = SGN < 0 ? make_float2(t3.y, -t3.x) : make_float2(-t3.y, t3.x);
    a0 = make_float2(t0.x + t2.x, t0.y + t2.y); a2 = make_float2(t0.x - t2.x, t0.y - t2.y);
    a1 = make_float2(t1.x + r.x, t1.y + r.y); a3 = make_float2(t1.x - r.x, t1.y - r.y);
}
template <int SGN> __device__ __forceinline__ void dft16(float2 (&x)[16]) {
#pragma unroll
    for (int q2 = 0; q2 < 4; ++q2) bfly4<SGN>(x[q2], x[q2 + 4], x[q2 + 8], x[q2 + 12]);
#pragma unroll
    for (int q2 = 1; q2 < 4; ++q2)
#pragma unroll
        for (int r1 = 1; r1 < 4; ++r1) { const int k = q2 * r1; const float2 w = make_float2(c16(k), (float)SGN * s16(k)); x[q2 + 4 * r1] = cmul(x[q2 + 4 * r1], w); }
#pragma unroll
    for (int r1 = 0; r1 < 4; ++r1) bfly4<SGN>(x[4 * r1], x[4 * r1 + 1], x[4 * r1 + 2], x[4 * r1 + 3]);
}
template <int M, int SGN> __device__ __forceinline__ void fft_pass16(float2* z, int tid) {
    constexpr int S = M / 16;
#pragma unroll 1
    for (int it = 0; it < 2; ++it) {
        int t = tid + it * 512; asm volatile("" : "+v"(t)); const int j = t & (S - 1); const int base = (t / S) * M;
        float2 tw[16];
        { const float ang = (float)j * (1.0f / (float)M); const float sn = __builtin_amdgcn_sinf(ang), cs = __builtin_amdgcn_cosf(ang);
          tw[0] = make_float2(1.f, 0.f); tw[1] = make_float2(cs, (float)SGN * sn); tw[2] = cmul(tw[1], tw[1]); tw[3] = cmul(tw[2], tw[1]); tw[4] = cmul(tw[2], tw[2]); tw[5] = cmul(tw[4], tw[1]); tw[6] = cmul(tw[3], tw[3]); tw[7] = cmul(tw[4], tw[3]);
          tw[8] = cmul(tw[4], tw[4]); tw[9] = cmul(tw[8], tw[1]); tw[10] = cmul(tw[5], tw[5]); tw[11] = cmul(tw[8], tw[3]); tw[12] = cmul(tw[6], tw[6]); tw[13] = cmul(tw[8], tw[5]); tw[14] = cmul(tw[7], tw[7]); tw[15] = cmul(tw[8], tw[7]); }
        float2 x[16];
#pragma unroll
        for (int q = 0; q < 16; ++q) x[q] = z[phys(base + j + q * S)];
        if (SGN > 0) {
#pragma unroll
            for (int q = 1; q < 16; ++q) x[q] = cmul(x[q], tw[q]); }
        dft16<SGN>(x);
#pragma unroll
        for (int pp = 0; pp < 16; ++pp) { const int r = (pp >> 2) + 4 * (pp & 3); float2 v = x[pp]; if (SGN < 0 && r > 0) v = cmul(v, tw[r]); z[phys(base + j + r * S)] = v; }
    }
}
__device__ __forceinline__ void fft_fwd3(float2* z, int tid) {
    fft_pass16<16384, -1>(z, tid); __syncthreads(); fft_pass16<1024, -1>(z, tid); __syncthreads(); fft_pass16<64, -1>(z, tid); __syncthreads();
}
__device__ __forceinline__ void fft_inv3(float2* z, int tid) {
    fft_pass16<64, 1>(z, tid); __syncthreads(); fft_pass16<1024, 1>(z, tid); __syncthreads(); fft_pass16<16384, 1>(z, tid); __syncthreads();
}
__device__ __forceinline__ void conv3x4(const bf16_t* seq, int l4, float w0, float w1, float w2, float bb, float (&o)[4]) {
    const uint2 w = *(const uint2*)(seq + l4);
    const float i1 = bflo(w.x), i2 = bfhi(w.x), i3 = bflo(w.y), i4 = bfhi(w.y);
    const float i0 = l4 > 0 ? bf2f(seq[l4 - 1]) : 0.f, i5 = (l4 + 4 < SEQ) ? bf2f(seq[l4 + 4]) : 0.f;
    o[0] = bb + w0 * i0 + w1 * i1 + w2 * i2; o[1] = bb + w0 * i1 + w1 * i2 + w2 * i3; o[2] = bb + w0 * i2 + w1 * i3 + w2 * i4; o[3] = bb + w0 * i3 + w1 * i4 + w2 * i5;
}
__device__ void hyena_unit(const Params& p, unsigned char* lds, int c) {
    const int tid = threadIdx.x, lane = tid & 63, wid = tid >> 6;
    float2* z = (float2*)lds; float* red = (float*)(lds + ZPHYS * 8);
    const bf16_t* HYT = (const bf16_t*)(p.ws + OFF_HYT); bf16_t* YHT = (bf16_t*)(p.ws + OFF_YHT);
    float2* KH = (float2*)(p.ws + OFF_KH) + (size_t)blockIdx.x * NFFT;
    const float* PS = (const float*)(p.ws + OFF_PS); const float* kf = (const float*)(p.ws + OFF_KF) + (size_t)c * NFFT;
    __syncthreads();
    { float part = 0.f; if (tid < 256) part = PS[tid * 1536 + c] + PS[tid * 1536 + DH + c];
      part = wave_sum(part); if (lane == 0 && wid < 4) red[wid] = part; }
    __syncthreads();
    const float scale = 1.0f / ((red[0] + red[1] + red[2] + red[3] + 1e-6f) * (float)NFFT);
#pragma unroll 1
    for (int it = 0; it < 8; ++it) { int e4 = (tid + 512 * it) * 4; asm volatile("" : "+v"(e4)); const float4 v = *(const float4*)(kf + e4); float4* d = (float4*)(z + phys(e4));
        d[0] = make_float4(v.x * scale, 0.f, v.y * scale, 0.f); d[1] = make_float4(v.z * scale, 0.f, v.w * scale, 0.f); }
    __syncthreads();
    fft_fwd3(z, tid);
#pragma unroll 1
    for (int it = 0; it < 8; ++it) { int e4 = (tid + 512 * it) * 4; asm volatile("" : "+v"(e4)); const float4* s = (const float4*)(z + phys(e4)); const float4 a = s[0], b = s[1];
        float2 x0 = make_float2(a.x, a.y), x1 = make_float2(a.z, a.w), x2 = make_float2(b.x, b.y), x3 = make_float2(b.z, b.w);
        bfly4<-1>(x0, x1, x2, x3);
        float4* d = (float4*)(KH + e4); d[0] = make_float4(x0.x, x0.y, x1.x, x1.y); d[1] = make_float4(x2.x, x2.y, x3.x, x3.y); }
    const float* cw = p.in[3]; const float* cb = p.in[4];
    const float wv0 = cw[c], wv1 = cw[2304 + c], wv2 = cw[4608 + c], bv = cb[c];
    const float wa0 = cw[DH + c], wa1 = cw[2304 + DH + c], wa2 = cw[4608 + DH + c], ba = cb[DH + c];
    const float wb0 = cw[2 * DH + c], wb1 = cw[2304 + 2 * DH + c], wb2 = cw[4608 + 2 * DH + c], bbq = cb[2 * DH + c];
    const float dskip = p.in[15][c];
    const bf16_t* sv = HYT + (size_t)c * NTOK; const bf16_t* sx0 = HYT + (size_t)(DH + c) * NTOK; const bf16_t* sx1 = HYT + (size_t)(2 * DH + c) * NTOK;
#pragma unroll 1
    for (int pr = 0; pr < 4; ++pr) {
        const size_t o0 = (size_t)(2 * pr) * SEQ, o1 = o0 + SEQ;
        __syncthreads();
#pragma unroll 1
        for (int it = 0; it < 4; ++it) { int l4 = (tid + 512 * it) * 4; asm volatile("" : "+v"(l4)); float v0[4], x10[4], v1[4], x11[4];
            conv3x4(sv + o0, l4, wv0, wv1, wv2, bv, v0); conv3x4(sx1 + o0, l4, wb0, wb1, wb2, bbq, x10);
            conv3x4(sv + o1, l4, wv0, wv1, wv2, bv, v1); conv3x4(sx1 + o1, l4, wb0, wb1, wb2, bbq, x11);
            float4* d = (float4*)(z + phys(l4));
            d[0] = make_float4(v0[0] * x10[0], v1[0] * x11[0], v0[1] * x10[1], v1[1] * x11[1]); d[1] = make_float4(v0[2] * x10[2], v1[2] * x11[2], v0[3] * x10[3], v1[3] * x11[3]);
            float4* dz = (float4*)(z + phys(SEQ + l4)); dz[0] = make_float4(0.f, 0.f, 0.f, 0.f); dz[1] = make_float4(0.f, 0.f, 0.f, 0.f); }
        __syncthreads();
        fft_fwd3(z, tid);
#pragma unroll 1
        for (int it = 0; it < 8; ++it) { int e4 = (tid + 512 * it) * 4; asm volatile("" : "+v"(e4)); float4* s = (float4*)(z + phys(e4)); const float4 a = s[0], b = s[1];
            float2 x0 = make_float2(a.x, a.y), x1 = make_float2(a.z, a.w), x2 = make_float2(b.x, b.y), x3 = make_float2(b.z, b.w);
            bfly4<-1>(x0, x1, x2, x3);
            const float4* kk = (const float4*)(KH + e4); const float4 ka = kk[0], kb = kk[1];
            x0 = cmul(x0, make_float2(ka.x, ka.y)); x1 = cmul(x1, make_float2(ka.z, ka.w)); x2 = cmul(x2, make_float2(kb.x, kb.y)); x3 = cmul(x3, make_float2(kb.z, kb.w));
            bfly4<1>(x0, x1, x2, x3);
            s[0] = make_float4(x0.x, x0.y, x1.x, x1.y); s[1] = make_float4(x2.x, x2.y, x3.x, x3.y); }
        __syncthreads();
        fft_inv3(z, tid);
#pragma unroll 1
        for (int it = 0; it < 4; ++it) { int l4 = (tid + 512 * it) * 4; asm volatile("" : "+v"(l4)); float v0[4], x10[4], v1[4], x11[4], x00[4], x01[4];
            conv3x4(sv + o0, l4, wv0, wv1, wv2, bv, v0); conv3x4(sx1 + o0, l4, wb0, wb1, wb2, bbq, x10); conv3x4(sx0 + o0, l4, wa0, wa1, wa2, ba, x00);
            conv3x4(sv + o1, l4, wv0, wv1, wv2, bv, v1); conv3x4(sx1 + o1, l4, wb0, wb1, wb2, bbq, x11); conv3x4(sx0 + o1, l4, wa0, wa1, wa2, ba, x01);
            const float4* s = (const float4*)(z + phys(l4)); const float4 a = s[0], b = s[1];
            const float cv0[4] = {a.x, a.z, b.x, b.z}, cv1[4] = {a.y, a.w, b.y, b.w};
            float y0[4], y1[4];
#pragma unroll
            for (int s4 = 0; s4 < 4; ++s4) { y0[s4] = x00[s4] * (cv0[s4] + dskip * (v0[s4] * x10[s4])); y1[s4] = x01[s4] * (cv1[s4] + dskip * (v1[s4] * x11[s4])); }
            uint2 w0; w0.x = pk(y0[0], y0[1]); w0.y = pk(y0[2], y0[3]); uint2 w1; w1.x = pk(y1[0], y1[1]); w1.y = pk(y1[2], y1[3]);
            *(uint2*)(YHT + (size_t)c * NTOK + o0 + l4) = w0; *(uint2*)(YHT + (size_t)c * NTOK + o1 + l4) = w1; }
    }
}
__device__ void lru_unit(const Params& p, unsigned char* lds, int unit) {
    const int tid = threadIdx.x, lane = tid & 63, wid = tid >> 6;
    const int dir = unit / 96, rem = unit % 96, b = rem / 12, h = rem % 12;
    bf16_t* INs = (bf16_t*)lds;
    bf16_t* XB = (bf16_t*)(lds + 16896);
    float* AA = (float*)(lds + 35328);
    float* BB = (float*)(lds + 70144);
    float2* CAR = (float2*)(lds + 104960);
    float* HC = (float*)(lds + 109056);
    uint4* WB = (uint4*)(lds + 109568);
    const bf16_t* src = (const bf16_t*)(p.ws + OFF_P2) + (size_t)b * SEQ * 2304 + DH + h * 64;
    bf16_t* dst = (bf16_t*)(p.ws + (dir ? OFF_HB : OFF_HF)) + (size_t)b * SEQ * DH + h * 64;
    const float* wa = p.in[18] + (size_t)(dir * 12 + h) * 4096; const float* wx = p.in[20] + (size_t)(dir * 12 + h) * 4096;
    __syncthreads();
    for (int entry = tid; entry < 1024; entry += 512) { const int f = entry >> 6, ln = entry & 63, g = f >> 3, ct = (f >> 1) & 3, ks = f & 1; const int k0 = 32 * ks + 8 * (ln >> 4), col = 16 * ct + (ln & 15);
        const float* W = g ? wx : wa; float v[8];
#pragma unroll
        for (int e = 0; e < 8; ++e) v[e] = W[(k0 + e) * 64 + col];
        uint4 w; w.x = pk(v[0], v[1]); w.y = pk(v[2], v[3]); w.z = pk(v[4], v[5]); w.w = pk(v[6], v[7]); WB[entry] = w; }
    if (tid < 128) HC[tid] = 0.f;
    const int oct = tid & 7;
    float cw[4][8], cbias[8];
#pragma unroll
    for (int e = 0; e < 8; ++e) { const int ch = h * 64 + oct * 8 + e; cbias[e] = p.in[17][ch];
#pragma unroll
        for (int k = 0; k < 4; ++k) cw[k][e] = p.in[16][k * DH + ch]; }
    float gba[4], gbx[4], sp8[4];
#pragma unroll
    for (int ct = 0; ct < 4; ++ct) { const int ch = dir * DH + h * 64 + 16 * ct + (lane & 15); gba[ct] = p.in[19][ch]; gbx[ct] = p.in[21][ch];
        const float e = __expf(-p.in[22][ch]); const float sp = (e < 0.02f) ? e * (1.0f - e * (0.5f - e * (1.0f / 3.0f))) : __logf(1.0f + e); sp8[ct] = 8.0f * sp; }
    uint4 R[3];
    { const int l0 = dir ? SEQ - 128 : 0;
#pragma unroll
      for (int i = 0; i < 3; ++i) { const int idx = tid + 512 * i, r = idx >> 3, o = idx & 7, l = l0 - 1 + r; const bool ok = (r < 131) && l >= 0 && l < SEQ;
          R[i] = ok ? *(const uint4*)(src + (size_t)l * 2304 + o * 8) : make_uint4(0u, 0u, 0u, 0u); } }
#pragma unroll 1
    for (int T = 0; T < 64; ++T) {
        const int l0 = dir ? SEQ - 128 * (T + 1) : 128 * T;
#pragma unroll
        for (int i = 0; i < 3; ++i) { const int idx = tid + 512 * i, r = idx >> 3, o = idx & 7; if (r < 132) *(uint4*)(INs + r * 64 + o * 8) = R[i]; }
        __syncthreads();
        if (T + 1 < 64) { const int l0n = dir ? SEQ - 128 * (T + 2) : 128 * (T + 1);
#pragma unroll
            for (int i = 0; i < 3; ++i) { const int idx = tid + 512 * i, r = idx >> 3, o = idx & 7, l = l0n - 1 + r; const bool ok = (r < 131) && l >= 0 && l < SEQ;
                R[i] = ok ? *(const uint4*)(src + (size_t)l * 2304 + o * 8) : make_uint4(0u, 0u, 0u, 0u); } }
#pragma unroll
        for (int i = 0; i < 2; ++i) { const int row = (tid + 512 * i) >> 3; float acc[8];
#pragma unroll
            for (int e = 0; e < 8; ++e) acc[e] = cbias[e];
#pragma unroll
            for (int k = 0; k < 4; ++k) { const uint4 w = *(const uint4*)(INs + (row + k) * 64 + oct * 8);
                acc[0] += cw[k][0] * bflo(w.x); acc[1] += cw[k][1] * bfhi(w.x); acc[2] += cw[k][2] * bflo(w.y); acc[3] += cw[k][3] * bfhi(w.y);
                acc[4] += cw[k][4] * bflo(w.z); acc[5] += cw[k][5] * bfhi(w.z); acc[6] += cw[k][6] * bflo(w.w); acc[7] += cw[k][7] * bfhi(w.w); }
            uint4 o; o.x = pk(acc[0], acc[1]); o.y = pk(acc[2], acc[3]); o.z = pk(acc[4], acc[5]); o.w = pk(acc[6], acc[7]);
            *(uint4*)(XB + row * 72 + oct * 8) = o; }
        __syncthreads();
        { const int rowA = 16 * wid + (lane & 15);
          const bf16x8_t a0 = *(const bf16x8_t*)(XB + rowA * 72 + 8 * (lane >> 4)), a1 = *(const bf16x8_t*)(XB + rowA * 72 + 32 + 8 * (lane >> 4));
          const int firstrow = dir ? 127 : 0;
#pragma unroll
          for (int ct = 0; ct < 4; ++ct) {
              f32x4_t accA = {0.f, 0.f, 0.f, 0.f}, accX = {0.f, 0.f, 0.f, 0.f};
              const uint4 b0 = WB[((0 * 4 + ct) * 2 + 0) * 64 + lane], b1 = WB[((0 * 4 + ct) * 2 + 1) * 64 + lane], b2 = WB[((1 * 4 + ct) * 2 + 0) * 64 + lane], b3 = WB[((1 * 4 + ct) * 2 + 1) * 64 + lane];
              accA = __builtin_amdgcn_mfma_f32_16x16x32_bf16(a0, __builtin_bit_cast(bf16x8_t, b0), accA, 0, 0, 0);
              accA = __builtin_amdgcn_mfma_f32_16x16x32_bf16(a1, __builtin_bit_cast(bf16x8_t, b1), accA, 0, 0, 0);
              accX = __builtin_amdgcn_mfma_f32_16x16x32_bf16(a0, __builtin_bit_cast(bf16x8_t, b2), accX, 0, 0, 0);
              accX = __builtin_amdgcn_mfma_f32_16x16x32_bf16(a1, __builtin_bit_cast(bf16x8_t, b3), accX, 0, 0, 0);
              const int ch = 16 * ct + (lane & 15);
#pragma unroll
              for (int j = 0; j < 4; ++j) { const int row = 16 * wid + 4 * (lane >> 4) + j;
                  const float r = sigm(accA[j] + gba[ct]), ig = sigm(accX[j] + gbx[ct]);
                  const float a = __expf(-sp8[ct] * r); float mult = sqrtf(fmaxf(1.0f - a * a, 0.f));
                  if (T == 0 && row == firstrow) mult = 1.0f;
                  const float xbv = bf2f(XB[row * 72 + ch]);
                  AA[row * 68 + ch] = a; BB[row * 68 + ch] = mult * ig * xbv; } } }
        __syncthreads();
        { float av[16], bv[16]; float P = 1.f, H = 0.f;
#pragma unroll
          for (int s = 0; s < 16; ++s) { const int row = dir ? 127 - (16 * wid + s) : 16 * wid + s; av[s] = AA[row * 68 + lane]; bv[s] = BB[row * 68 + lane]; H = av[s] * H + bv[s]; P *= av[s]; }
          CAR[wid * 64 + lane] = make_float2(P, H);
          __syncthreads();
          float hin = HC[(T & 1) * 64 + lane];
          for (int s2 = 0; s2 < wid; ++s2) { const float2 c2 = CAR[s2 * 64 + lane]; hin = c2.x * hin + c2.y; }
#pragma unroll
          for (int s = 0; s < 16; ++s) { const int row = dir ? 127 - (16 * wid + s) : 16 * wid + s; hin = av[s] * hin + bv[s]; AA[row * 68 + lane] = hin; }
          if (wid == 7) HC[((T + 1) & 1) * 64 + lane] = hin; }
        __syncthreads();
#pragma unroll
        for (int i = 0; i < 2; ++i) { const int row = (tid + 512 * i) >> 3; const float4 v0 = *(const float4*)(AA + row * 68 + oct * 8), v1 = *(const float4*)(AA + row * 68 + oct * 8 + 4);
            uint4 o; o.x = pk(v0.x, v0.y); o.y = pk(v0.z, v0.w); o.z = pk(v1.x, v1.y); o.w = pk(v1.z, v1.w);
            *(uint4*)(dst + (size_t)(l0 + row) * DH + oct * 8) = o; }
    }
}
__device__ void phase_mix(const Params& p, unsigned char* lds) {
    unsigned* ctr = (unsigned*)(p.ws + OFF_CTL); volatile int* slot = (volatile int*)(lds + LDS_BYTES - 16);
    for (;;) {
        __syncthreads();
        if (threadIdx.x == 0) *slot = (int)atomicAdd(ctr, 1u);
        __syncthreads();
        const int u = *slot;
        if (u >= N_LRU_UNITS + N_HY_UNITS) break;
        if (u < N_LRU_UNITS) { if (MIX_SEL != 2) lru_unit(p, lds, u); } else { if (MIX_SEL != 1) hyena_unit(p, lds, u - N_LRU_UNITS); }
    }
}
__device__ void phase_ycat(const Params& p, unsigned char* lds) {
    const int tid = threadIdx.x, lane = tid & 63, wid = tid >> 6;
    unsigned* T = (unsigned*)lds; const unsigned short* Th = (const unsigned short*)lds;
    const bf16_t* YHT = (const bf16_t*)(p.ws + OFF_YHT); const bf16_t* P2 = (const bf16_t*)(p.ws + OFF_P2);
    const bf16_t* HF = (const bf16_t*)(p.ws + OFF_HF); const bf16_t* HB = (const bf16_t*)(p.ws + OFF_HB); bf16_t* YC = (bf16_t*)(p.ws + OFF_YCAT);
    float hg[12], lg[12];
#pragma unroll
    for (int m = 0; m < 6; ++m) { hg[2 * m] = p.in[23][2 * lane + 128 * m]; hg[2 * m + 1] = p.in[23][2 * lane + 128 * m + 1]; }
#pragma unroll
    for (int m = 0; m < 3; ++m)
#pragma unroll
        for (int e = 0; e < 4; ++e) lg[4 * m + e] = p.in[24][4 * lane + 256 * m + e];
    for (int tile = blockIdx.x; tile < NTOK / 64; tile += gridDim.x) {
        const int tok0 = tile * 64;
        __syncthreads();
#pragma unroll 1
        for (int i = 0; i < 12; ++i) { const int idx = tid + 512 * i, c = idx >> 3, seg = idx & 7; const uint4 w = *(const uint4*)(YHT + (size_t)c * NTOK + tok0 + seg * 8);
            unsigned* d = T + c * 33 + seg * 4; d[0] = w.x; d[1] = w.y; d[2] = w.z; d[3] = w.w; }
        __syncthreads();
#pragma unroll 1
        for (int i = 0; i < 8; ++i) { const int t = 8 * wid + i; const size_t tok = (size_t)tok0 + t;
            float y[12]; float ss = 0.f;
#pragma unroll
            for (int m = 0; m < 6; ++m) { const int c = 2 * lane + 128 * m; y[2 * m] = bf2f(Th[c * 66 + t]); y[2 * m + 1] = bf2f(Th[(c + 1) * 66 + t]); ss += y[2 * m] * y[2 * m] + y[2 * m + 1] * y[2 * m + 1]; }
            ss = wave_sum(ss); const float rs = rsqrtf(ss * (1.0f / DH) + 1e-6f);
#pragma unroll
            for (int m = 0; m < 6; ++m) { const int c = 2 * lane + 128 * m; const unsigned gw = *(const unsigned*)(P2 + tok * 2304 + c); const float g0 = bflo(gw), g1 = bfhi(gw);
                const float o0 = y[2 * m] * rs * hg[2 * m] * (g0 * sigm(g0)), o1 = y[2 * m + 1] * rs * hg[2 * m + 1] * (g1 * sigm(g1));
                *(unsigned*)(YC + tok * 1536 + c) = pk(o0, o1); }
            float q[12]; float s2 = 0.f;
#pragma unroll
            for (int m = 0; m < 3; ++m) { const int c = 4 * lane + 256 * m; const uint2 f = *(const uint2*)(HF + tok * DH + c), bq = *(const uint2*)(HB + tok * DH + c);
                q[4 * m] = bflo(f.x) + bflo(bq.x); q[4 * m + 1] = bfhi(f.x) + bfhi(bq.x); q[4 * m + 2] = bflo(f.y) + bflo(bq.y); q[4 * m + 3] = bfhi(f.y) + bfhi(bq.y);
                s2 += q[4 * m] * q[4 * m] + q[4 * m + 1] * q[4 * m + 1] + q[4 * m + 2] * q[4 * m + 2] + q[4 * m + 3] * q[4 * m + 3]; }
            s2 = wave_sum(s2); const float rs2 = rsqrtf(s2 * (1.0f / DH) + 1e-6f);
#pragma unroll
            for (int m = 0; m < 3; ++m) { const int c = 4 * lane + 256 * m; const uint2 gw = *(const uint2*)(P2 + tok * 2304 + 1536 + c);
                const float g0 = bflo(gw.x), g1 = bfhi(gw.x), g2 = bflo(gw.y), g3 = bfhi(gw.y);
                uint2 o; o.x = pk(q[4 * m] * rs2 * lg[4 * m] * (g0 * sigm(g0)), q[4 * m + 1] * rs2 * lg[4 * m + 1] * (g1 * sigm(g1)));
                o.y = pk(q[4 * m + 2] * rs2 * lg[4 * m + 2] * (g2 * sigm(g2)), q[4 * m + 3] * rs2 * lg[4 * m + 3] * (g3 * sigm(g3)));
                *(uint2*)(YC + tok * 1536 + DH + c) = o; }
        }
    }
}
__device__ void phase_final(const Params& p) {
    const int tid = threadIdx.x, lane = tid & 63, wid = tid >> 6;
    const float4* g4 = (const float4*)p.in[26]; float4 gv[4];
#pragma unroll
    for (int i = 0; i < 4; ++i) gv[i] = g4[i * 64 + lane];
    for (int row = blockIdx.x * 8 + wid; row < NTOK; row += gridDim.x * 8) {
        float4* src = (float4*)(p.out + (size_t)row * DM);
        float4 v[4]; float ss = 0.f;
#pragma unroll
        for (int i = 0; i < 4; ++i) { v[i] = src[i * 64 + lane]; ss += v[i].x * v[i].x + v[i].y * v[i].y + v[i].z * v[i].z + v[i].w * v[i].w; }
        ss = wave_sum(ss);
        const float rs = rsqrtf(ss * (1.0f / DM) + 1e-6f);
#pragma unroll
        for (int i = 0; i < 4; ++i) src[i * 64 + lane] = make_float4(v[i].x * rs * gv[i].x, v[i].y * rs * gv[i].y, v[i].z * rs * gv[i].z, v[i].w * rs * gv[i].w);
    }
}
constexpr int N_PHASES = 6;
__global__ void __launch_bounds__(512) hymba_fwd(Params p) {
    extern __shared__ __attribute__((aligned(16))) unsigned char lds[];
    cg::grid_group grid = cg::this_grid();
#ifndef ONLY_PHASE
#define ONLY_PHASE -1
#endif
#define PH_ON(n) (ONLY_PHASE < 0 || ONLY_PHASE == (n))
    const int lo = p.ph_lo, hi = p.ph_hi;
    if (lo <= 0 && 0 < hi) { if (PH_ON(0)) phase0(p, lds); }
    if (lo <= 1 && 1 < hi) { if (lo < 1) grid.sync(); if (PH_ON(1)) phase_gemm1(p, lds); }
    if (lo <= 2 && 2 < hi) { if (lo < 2) grid.sync(); if (PH_ON(2)) phase_mix(p, lds); }
    if (lo <= 3 && 3 < hi) { if (lo < 3) grid.sync(); if (PH_ON(3)) phase_ycat(p, lds); }
    if (lo <= 4 && 4 < hi) { if (lo < 4) grid.sync(); if (PH_ON(4)) phase_gemm2(p, lds); }
    if (lo <= 5 && 5 < hi) { if (lo < 5) grid.sync(); if (PH_ON(5)) phase_final(p); }
}
extern "C" void kernel_launch(void* const* d_in, const int* in_sizes, int n_in, void* d_out, int out_size, void* d_ws, size_t ws_size, hipStream_t stream) {
    static int grid = 0;
    if (grid == 0) {
        if (n_in != 27 || ws_size < WS_END) { fprintf(stderr, "kernel_launch: expected 27 inputs and >= %zu bytes of workspace (got %d, %zu)\n", (size_t)WS_END, n_in, ws_size); grid = -1; return; }
        int dev = 0, cus = 0, per_cu = 0;
        hipGetDevice(&dev); hipDeviceGetAttribute(&cus, hipDeviceAttributeMultiprocessorCount, dev);
        if (hipFuncSetAttribute((const void*)hymba_fwd, hipFuncAttributeMaxDynamicSharedMemorySize, LDS_BYTES) != hipSuccess) { fprintf(stderr, "kernel_launch: hipFuncSetAttribute failed\n"); grid = -1; return; }
        if (hipOccupancyMaxActiveBlocksPerMultiprocessor(&per_cu, (const void*)hymba_fwd, 512, LDS_BYTES) != hipSuccess || per_cu < 1) { fprintf(stderr, "kernel_launch: occupancy query failed (%d)\n", per_cu); (void)hipGetLastError(); grid = -1; return; }
        grid = cus * per_cu; if (grid > 256) grid = 256;
    }
    if (grid < 0) return;
    hipMemsetAsync((char*)d_ws + OFF_CTL, 0, 256, stream);
    Params p{};
    for (int i = 0; i < 27; ++i) p.in[i] = (const float*)d_in[i];
    p.out = (float*)d_out; p.ws = (unsigned char*)d_ws;
    const int per = (N_PHASES + MK_N_LAUNCHES - 1) / MK_N_LAUNCHES;
    for (int lo = 0; lo < N_PHASES; lo += per) {
        p.ph_lo = lo; p.ph_hi = lo + per < N_PHASES ? lo + per : N_PHASES;
        void* args[] = {&p};
        const hipError_t e = hipLaunchCooperativeKernel((const void*)hymba_fwd, dim3(grid), dim3(512), args, LDS_BYTES, stream);
        if (e != hipSuccess) { fprintf(stderr, "kernel_launch: cooperative launch failed: %s (grid %d)\n", hipGetErrorString(e), grid); break; }
    }
}
```

```cpp
#include <hip/hip_runtime.h>
#include <hip/hip_cooperative_groups.h>
#include <cstdio>
namespace cg = cooperative_groups;
#ifndef MK_N_LAUNCHES
#define MK_N_LAUNCHES 1
#endif
namespace pg8 {
#define PG8_LAS __attribute__((address_space(3)))
typedef unsigned short bf16_t;
typedef short bf16x8 __attribute__((ext_vector_type(8)));
typedef float f32x4 __attribute__((ext_vector_type(4)));
typedef unsigned u32x4 __attribute__((ext_vector_type(4)));
constexpr int BM = 256, BK = 64, HALF = 128, HTB = HALF * BK * 2  , STAGE_BYTES = 8 * HTB, NXCD = 8, WGM = 8;

__host__ __device__ __forceinline__ int lds_byte(int r, int c) { const int st = (r >> 4) * 2 + (c >> 5), rr = r & 15, cc = c & 31, ob = rr * 64 + cc * 2; return st * 1024 + (ob ^ (((ob >> 9) & 1) << 5)); }
__host__ __device__ __forceinline__ void stage_rc(int b, int& R, int& C) { const int st = b / 1024, sb = b % 1024, swz = sb ^ (((sb >> 9) & 1) << 5); R = (st >> 1) * 16 + swz / 64; C = (st & 1) * 32 + (swz % 64) / 2; }
__host__ __device__ __forceinline__ int perm32(int rho) { const int n = rho >> 4, i = rho & 15; return 8 * (i >> 2) + 4 * n + (i & 3); }

struct Unit { int pm, pn; };
struct Gemm { const bf16_t* A; const bf16_t* Bt; int M, N, K; };

struct StaticOrder {
    int nM, nN, nwg, G, c;
    __host__ __device__ void init(int M, int N, int G_, int c_) { nM = M / BM; nN = N / BM; nwg = nM * nN; G = G_; c = c_; }
    __host__ __device__ bool next(int i, Unit& u) const {
        const long L = (long)i * G + c; if (L >= nwg) return false;
        int wgid = (int)L; { const int q = nwg / NXCD, r = nwg % NXCD, xcd = wgid % NXCD, off = wgid / NXCD; wgid = (xcd < r ? xcd * (q + 1) : r * (q + 1) + (xcd - r) * q) + off; }
        const int nig = WGM * nN, gid = wgid / nig, fm = gid * WGM, gsz = (nM - fm) < WGM ? (nM - fm) : WGM;
        u.pm = fm + ((wgid % nig) % gsz); u.pn = (wgid % nig) / gsz; return true;
    }
    __device__ __forceinline__ void a_ready(const Unit&) const {}
    __device__ __forceinline__ void done(const Unit&) const {}
};
__device__ __forceinline__ unsigned cvt_pk_bf16(float lo, float hi) { unsigned r; asm volatile("v_cvt_pk_bf16_f32 %0, %1, %2" : "=v"(r) : "v"(lo), "v"(hi)); return r; }
typedef float f32x2 __attribute__((ext_vector_type(2)));

struct EpiStoreBf16 {
    static constexpr bool PERM = true, AFTER_DRAIN = false;
    bf16_t* O; int ldc;
    __device__ __forceinline__ void operator()(const f32x4 (&acc)[2][2][4][2], const Unit& u, int wr, int wc, int fr, int fq) const {
        const int row0 = u.pm * BM + wr * 64 + fr; const int col0 = u.pn * BM + wc * 32 + 8 * fq;
#pragma unroll
        for (int ai = 0; ai < 2; ++ai)
#pragma unroll
            for (int m = 0; m < 4; ++m) { bf16_t* rowp = O + (size_t)(row0 + ai * HALF + m * 16) * ldc + col0;
#pragma unroll
                for (int bj = 0; bj < 2; ++bj) { const f32x4 v0 = acc[ai][bj][m][0], v1 = acc[ai][bj][m][1];
                    u32x4 w; w.x = cvt_pk_bf16(v0[0], v0[1]); w.y = cvt_pk_bf16(v0[2], v0[3]); w.z = cvt_pk_bf16(v1[0], v1[1]); w.w = cvt_pk_bf16(v1[2], v1[3]);
                    *(u32x4*)(rowp + bj * HALF) = w; } }
    }
};
struct EpiResidF32 {
    static constexpr bool PERM = false, AFTER_DRAIN = false;
    float* C; const float* X; int ldc;
    __device__ __forceinline__ void operator()(const f32x4 (&acc)[2][2][4][2], const Unit& u, int wr, int wc, int fr, int fq) const {
        const int row0 = u.pm * BM + wr * 64 + fr, col0 = u.pn * BM + wc * 32 + 4 * fq;
#pragma unroll
        for (int ai = 0; ai < 2; ++ai)
#pragma unroll
            for (int m = 0; m < 4; ++m) { const size_t off = (size_t)(row0 + ai * HALF + m * 16) * ldc + col0;
#pragma unroll
                for (int bj = 0; bj < 2; ++bj)
#pragma unroll
                    for (int n = 0; n < 2; ++n) { const f32x4 xv = *(const f32x4*)(X + off + bj * HALF + n * 16); *(f32x4*)(C + off + bj * HALF + n * 16) = acc[ai][bj][m][n] + xv; } }
    }
};
struct OneUnit {
    int pm, pn;
    __device__ __forceinline__ bool next(int i, Unit& u) const { if (i) return false; u.pm = pm; u.pn = pn; return true; }
    __device__ __forceinline__ void a_ready(const Unit&) const {}
    __device__ __forceinline__ void done(const Unit&) const {}
};
struct EpiFinal {
    static constexpr bool PERM = false, AFTER_DRAIN = true;
    float* C; const float* X; const float* G; float* rowsq; unsigned* cnt;
    __device__ __forceinline__ void fused(f32x4 (&acc)[2][2][4][2], const Unit& u, int wr, int wc, int fr, int fq, PG8_LAS unsigned char* lds, int wid, int lane) const {
        PG8_LAS float* P = (PG8_LAS float*)lds;
        PG8_LAS float* S = (PG8_LAS float*)(lds + 4096);
        const int tid = wid * 64 + lane;
        const int row0 = u.pm * BM + wr * 64 + fr, col0 = u.pn * BM + wc * 32 + 4 * fq;
#pragma unroll
        for (int ai = 0; ai < 2; ++ai)
#pragma unroll
            for (int m = 0; m < 4; ++m) { const size_t off = (size_t)(row0 + ai * HALF + m * 16) * 1024 + col0; float s = 0.f;
#pragma unroll
                for (int bj = 0; bj < 2; ++bj)
#pragma unroll
                    for (int n = 0; n < 2; ++n) { const f32x4 xv = *(const f32x4*)(X + off + bj * HALF + n * 16); const f32x4 v = acc[ai][bj][m][n] + xv; acc[ai][bj][m][n] = v;
                        s += (v[0] * v[0] + v[1] * v[1]) + (v[2] * v[2] + v[3] * v[3]); }
                s += __shfl_xor(s, 16); s += __shfl_xor(s, 32);
                if (fq == 0) P[(ai * HALF + wr * 64 + m * 16 + fr) * 4 + wc] = s; }
        __syncthreads();
        { float back = 0.f;
          if (tid < 256) { const float tot = (P[tid * 4] + P[tid * 4 + 1]) + (P[tid * 4 + 2] + P[tid * 4 + 3]);
              back = __hip_atomic_fetch_add(rowsq + u.pm * BM + tid, tot, __ATOMIC_RELAXED, __HIP_MEMORY_SCOPE_AGENT); }
          asm volatile("s_waitcnt vmcnt(0)" :: "v"(back) : "memory"); }
        __syncthreads();
        if (tid == 0) {
            __hip_atomic_fetch_add(cnt + u.pm, 1u, __ATOMIC_RELAXED, __HIP_MEMORY_SCOPE_AGENT);
            unsigned sp = 0;
            while (__hip_atomic_load(cnt + u.pm, __ATOMIC_RELAXED, __HIP_MEMORY_SCOPE_AGENT) < 4u) { __builtin_amdgcn_s_sleep(1); if (++sp > (1u << 22)) break; }
        }
        __syncthreads();
        if (tid < 256) S[tid] = __builtin_amdgcn_rsqf(__hip_atomic_load(rowsq + u.pm * BM + tid, __ATOMIC_RELAXED, __HIP_MEMORY_SCOPE_AGENT) * (1.0f / 1024.0f) + 1e-6f);
        __syncthreads();
        f32x4 gv[2][2];
#pragma unroll
        for (int bj = 0; bj < 2; ++bj)
#pragma unroll
            for (int n = 0; n < 2; ++n) gv[bj][n] = *(const f32x4*)(G + col0 + bj * HALF + n * 16);
#pragma unroll
        for (int ai = 0; ai < 2; ++ai)
#pragma unroll
            for (int m = 0; m < 4; ++m) { const size_t off = (size_t)(row0 + ai * HALF + m * 16) * 1024 + col0; const float rs = S[ai * HALF + wr * 64 + m * 16 + fr];
#pragma unroll
                for (int bj = 0; bj < 2; ++bj)
#pragma unroll
                    for (int n = 0; n < 2; ++n) *(f32x4*)(C + off + bj * HALF + n * 16) = acc[ai][bj][m][n] * rs * gv[bj][n]; }
        __syncthreads();
    }
};
template <class Epi, class Sched, bool STAMP = false>
__device__ __forceinline__ void gemm_phase(PG8_LAS unsigned char* lds, const Gemm g, const Sched& S, const Epi& E, unsigned long long* stamps) {
    const int tid = threadIdx.x, wid = __builtin_amdgcn_readfirstlane(tid >> 6), lane = tid & 63, wr = wid >> 2, wc = wid & 3, fr = lane & 15, fq = lane >> 4;
    const int K = g.K, nt = K / BK;
    int ts_lo = 0, ts_hi = 0, nts = 0; const unsigned long long rt_entry = STAMP ? (unsigned long long)wall_clock64() : 0ull;
#define PG8_STAMP() do { if (STAMP && wid == 0 && nts < 64) { const unsigned long long _c = (unsigned long long)clock64(); \
        ts_lo = (lane == nts) ? (int)(unsigned)_c : ts_lo; ts_hi = (lane == nts) ? (int)(unsigned)(_c >> 32) : ts_hi; ++nts; } } while (0)
    PG8_STAMP();
    unsigned voffA[2], voffB[2];
#pragma unroll
    for (int i = 0; i < 2; ++i) { int R, C; stage_rc(tid * 16 + i * 8192, R, C); const int Rb = Epi::PERM ? ((R & ~31) + perm32(R & 31)) : R;
        voffA[i] = (unsigned)(R * K + C) * 2u; voffB[i] = (unsigned)(Rb * K + C) * 2u; }
    const size_t kstep = (size_t)(BK * 2);
    const size_t hstep = (size_t)HALF * K * 2;
    const size_t tstep = 2 * hstep;
    const unsigned ldsw = (unsigned)wid * 1024u;
    const int aoff = lds_byte(wr * 64 + fr, fq * 8), boff = lds_byte(wc * 32 + fr, fq * 8);
#define PG8_SA(b, h) (((b) * 2 + (h)) * HTB)
#define PG8_SB(b, h) ((4 + (b) * 2 + (h)) * HTB)
#define PG8_STAGE(bufoff, gbase, voff) do { _Pragma("unroll") for (int _i = 0; _i < 2; ++_i) \
        __builtin_amdgcn_global_load_lds((const unsigned*)((const char*)(gbase) + (voff)[_i]), (PG8_LAS unsigned*)(lds + (bufoff) + ldsw + _i * 8192), 16, 0, 0); } while (0)
#define PG8_LDA(dst, b, h) do { _Pragma("unroll") for (int m = 0; m < 4; ++m) _Pragma("unroll") for (int k = 0; k < 2; ++k) dst[m][k] = *(const PG8_LAS bf16x8*)(lds + PG8_SA(b, h) + aoff + m * 2048 + k * 1024); } while (0)
#define PG8_LDB(dst, b, h) do { _Pragma("unroll") for (int n = 0; n < 2; ++n) _Pragma("unroll") for (int k = 0; k < 2; ++k) dst[n][k] = *(const PG8_LAS bf16x8*)(lds + PG8_SB(b, h) + boff + n * 2048 + k * 1024); } while (0)
#define PG8_MMA(ai, bj, At, Bt) do { __builtin_amdgcn_s_setprio(1); _Pragma("unroll") for (int m = 0; m < 4; ++m) _Pragma("unroll") for (int n = 0; n < 2; ++n) _Pragma("unroll") for (int k = 0; k < 2; ++k) \
        acc[ai][bj][m][n] = __builtin_amdgcn_mfma_f32_16x16x32_bf16(Bt[n][k], At[m][k], acc[ai][bj][m][n], 0, 0, 0); __builtin_amdgcn_s_setprio(0); } while (0)
#define PG8_WAIT_V(n) asm volatile("s_waitcnt vmcnt(" #n ")" ::: "memory")
#define PG8_WAIT_L(n) asm volatile("s_waitcnt lgkmcnt(" #n ")" ::: "memory")
#define PG8_BAR __builtin_amdgcn_s_barrier()
#define PG8_SCHED __builtin_amdgcn_sched_barrier(0)
    Unit cur, nxt; int ui = 0;
    if (!S.next(0, cur)) return;
    f32x4 acc[2][2][4][2];
#pragma unroll
    for (int a = 0; a < 2; ++a)
#pragma unroll
        for (int b = 0; b < 2; ++b)
#pragma unroll
            for (int m = 0; m < 4; ++m)
#pragma unroll
                for (int n = 0; n < 2; ++n) acc[a][b][m][n] = (f32x4){0.f, 0.f, 0.f, 0.f};
    bf16x8 At[4][2], B0[2][2], B1[2][2];
    const char* cA = (const char*)g.A + (size_t)cur.pm * tstep; const char* cB = (const char*)g.Bt + (size_t)cur.pn * tstep;
    S.a_ready(cur);
    PG8_STAGE(PG8_SB(0, 0), cB, voffB); PG8_STAGE(PG8_SA(0, 0), cA, voffA); PG8_STAGE(PG8_SB(0, 1), cB + hstep, voffB); PG8_STAGE(PG8_SA(0, 1), cA + hstep, voffA);
    if (wr == 1) PG8_BAR;
    PG8_WAIT_V(4); PG8_BAR;
    PG8_STAGE(PG8_SB(1, 0), cB + kstep, voffB); PG8_STAGE(PG8_SA(1, 0), cA + kstep, voffA); PG8_STAGE(PG8_SB(1, 1), cB + hstep + kstep, voffB);
    PG8_WAIT_V(6); PG8_BAR;
    PG8_STAMP();
    for (;;) {
        const bool has_next = S.next(ui + 1, nxt);
        const char* nA = has_next ? (const char*)g.A + (size_t)nxt.pm * tstep : cA; const char* nB = has_next ? (const char*)g.Bt + (size_t)nxt.pn * tstep : cB;
        for (int t = 0; t < nt; t += 2) {
            const bool last = (t == nt - 2);
            const char* a1 = cA + (size_t)(t + 1) * kstep;
            const char* a2 = last ? nA : cA + (size_t)(t + 2) * kstep; const char* b2 = last ? nB : cB + (size_t)(t + 2) * kstep;
            const char* a3 = a2 + kstep; const char* b3 = b2 + kstep;
            if (last && has_next) S.a_ready(nxt);
            PG8_LDB(B0, 0, 0); PG8_SCHED; PG8_LDA(At, 0, 0); PG8_STAGE(PG8_SA(1, 1), a1 + hstep, voffA);
            PG8_WAIT_L(8); PG8_BAR; PG8_WAIT_L(0); PG8_MMA(0, 0, At, B0); PG8_BAR; PG8_SCHED;
            PG8_LDB(B1, 0, 1); PG8_STAGE(PG8_SB(0, 0), b2, voffB);
            PG8_BAR; PG8_WAIT_L(0); PG8_MMA(0, 1, At, B1); PG8_BAR;
            PG8_LDA(At, 0, 1); PG8_STAGE(PG8_SA(0, 0), a2, voffA);
            PG8_BAR; PG8_WAIT_L(0); PG8_MMA(1, 0, At, B0); PG8_BAR; PG8_SCHED;
            PG8_STAGE(PG8_SB(0, 1), b2 + hstep, voffB);
            PG8_WAIT_V(6); PG8_BAR; PG8_MMA(1, 1, At, B1); PG8_BAR;
            PG8_LDB(B0, 1, 0); PG8_SCHED; PG8_LDA(At, 1, 0); PG8_STAGE(PG8_SA(0, 1), a2 + hstep, voffA);
            PG8_WAIT_L(8); PG8_BAR; PG8_WAIT_L(0); PG8_MMA(0, 0, At, B0); PG8_BAR; PG8_SCHED;
            PG8_LDB(B1, 1, 1); PG8_STAGE(PG8_SB(1, 0), b3, voffB);
            PG8_BAR; PG8_WAIT_L(0); PG8_MMA(0, 1, At, B1); PG8_BAR;
            PG8_LDA(At, 1, 1); PG8_STAGE(PG8_SA(1, 0), a3, voffA);
            PG8_BAR; PG8_WAIT_L(0); PG8_MMA(1, 0, At, B0); PG8_BAR; PG8_SCHED;
            PG8_STAGE(PG8_SB(1, 1), b3 + hstep, voffB);
            PG8_WAIT_V(6); PG8_BAR; PG8_MMA(1, 1, At, B1); PG8_BAR;
        }
        PG8_STAMP();
        if constexpr (!Epi::AFTER_DRAIN) { E(acc, cur, wr, wc, fr, fq); S.done(cur); }
        PG8_STAMP();
        if (!has_next) break;
#pragma unroll
        for (int a = 0; a < 2; ++a)
#pragma unroll
            for (int b = 0; b < 2; ++b)
#pragma unroll
                for (int m = 0; m < 4; ++m)
#pragma unroll
                    for (int n = 0; n < 2; ++n) acc[a][b][m][n] = (f32x4){0.f, 0.f, 0.f, 0.f};
        cur = nxt; cA = nA; cB = nB; ++ui;
    }
    PG8_WAIT_V(0);
    if (wr == 0) PG8_BAR;
    PG8_BAR;
    if constexpr (Epi::AFTER_DRAIN) { E.fused(acc, cur, wr, wc, fr, fq, lds, wid, lane); S.done(cur); }
    PG8_STAMP();
    if (STAMP && wid == 0) { stamps[lane] = lane < nts ? (((unsigned long long)(unsigned)ts_hi << 32) | (unsigned)ts_lo) : 0ull;
        if (lane == 62) stamps[62] = rt_entry; if (lane == 63) stamps[63] = (unsigned long long)wall_clock64(); }
#undef PG8_STAMP
#undef PG8_SA
#undef PG8_SB
#undef PG8_STAGE
#undef PG8_LDA
#undef PG8_LDB
#undef PG8_MMA
#undef PG8_WAIT_V
#undef PG8_WAIT_L
#undef PG8_BAR
#undef PG8_SCHED
}
}

using pg8::bf16_t;
typedef short bf16x8_t __attribute__((ext_vector_type(8)));
typedef float f32x4_t __attribute__((ext_vector_type(4)));

constexpr int NB = 8, SEQ = 8192, DM = 1024, DH = 768, NTOK = NB * SEQ;
constexpr size_t MiB = 1ull << 20;
constexpr size_t OFF_XN = 0, OFF_YHT = 0, OFF_HYT = 128 * MiB, OFF_YCAT = 128 * MiB, OFF_P2 = 416 * MiB, OFF_KF = 704 * MiB, OFF_KH = 752 * MiB,
                 OFF_HF = 784 * MiB, OFF_HB = 880 * MiB, OFF_WT1 = 976 * MiB, OFF_WT2 = 985 * MiB, OFF_PS = 988 * MiB, OFF_CTL = 990 * MiB, OFF_XBAR = OFF_CTL + 16384, OFF_CNT = OFF_CTL + 4096, OFF_ROWSQ = OFF_CTL + 65536, WS_END = 991 * MiB;
constexpr int NFFT = 16384;
constexpr int ZPHYS = NFFT + (NFFT / 64) * 4;
constexpr int LDS_BYTES = ZPHYS * 8 + 256;
constexpr int N_LRU_UNITS = 192, N_HY_UNITS = 768, N_HY_FULL = 640;
#ifndef MIX_SEL
#define MIX_SEL 0
#endif

struct Params { const float* in[27]; float* out; unsigned char* ws; int ph_lo, ph_hi; };

__device__ __forceinline__ float bf2f(unsigned short b) { return __uint_as_float(((unsigned)b) << 16); }
__device__ __forceinline__ float bflo(unsigned w) { return __uint_as_float(w << 16); }
__device__ __forceinline__ float bfhi(unsigned w) { return __uint_as_float(w & 0xffff0000u); }
__device__ __forceinline__ unsigned pk(float a, float b) { return pg8::cvt_pk_bf16(a, b); }
__device__ __forceinline__ float wave_sum(float v) {
#pragma unroll
    for (int o = 32; o; o >>= 1) v += __shfl_xor(v, o);
    return v; }
__device__ __forceinline__ float sigm(float x) { return __builtin_amdgcn_rcpf(1.0f + __expf(-x)); }
__device__ __forceinline__ float sin_rad(float x) { const float r = x * 0.15915494309189535f; return __builtin_amdgcn_sinf(r - floorf(r)); }
__device__ __forceinline__ float cos_rad(float x) { const float r = x * 0.15915494309189535f; return __builtin_amdgcn_cosf(r - floorf(r)); }

__device__ void phase_xn(const Params& p) {
    const int tid = threadIdx.x, lane = tid & 63, wid = tid >> 6;
    const float* x = p.in[0]; bf16_t* XN = (bf16_t*)(p.ws + OFF_XN);
    for (int row = (blockIdx.x * 8 + wid) * 4; row < NTOK; row += gridDim.x * 32) {
        float4 v[4][4]; float ss[4];
#pragma unroll
        for (int r = 0; r < 4; ++r) { const float4* src = (const float4*)(x + (size_t)(row + r) * DM);
#pragma unroll
            for (int i = 0; i < 4; ++i) v[r][i] = src[i * 64 + lane]; }
#pragma unroll
        for (int r = 0; r < 4; ++r) { float s = 0.f;
#pragma unroll
            for (int i = 0; i < 4; ++i) s += v[r][i].x * v[r][i].x + v[r][i].y * v[r][i].y + v[r][i].z * v[r][i].z + v[r][i].w * v[r][i].w;
            ss[r] = wave_sum(s); }
#pragma unroll
        for (int r = 0; r < 4; ++r) { const float rs = rsqrtf(ss[r] * (1.0f / DM) + 1e-6f); uint2* dst = (uint2*)(XN + (size_t)(row + r) * DM);
#pragma unroll
            for (int i = 0; i < 4; ++i) { uint2 w; w.x = pk(v[r][i].x * rs, v[r][i].y * rs); w.y = pk(v[r][i].z * rs, v[r][i].w * rs); dst[i * 64 + lane] = w; } }
    }
}
__device__ void transpose_to_bf16(const float* src, int R, int C, const float* rowscale, bf16_t* dst, float* tile) {
    const int tid = threadIdx.x; const int tc = C / 64, nt = (R / 64) * tc;
    for (int t = blockIdx.x; t < nt; t += gridDim.x) {
        const int r0 = (t / tc) * 64, c0 = (t % tc) * 64;
        __syncthreads();
#pragma unroll
        for (int i = 0; i < 2; ++i) { const int r = (tid >> 4) + 32 * i, c4 = (tid & 15) * 4;
            const float4 v = *(const float4*)(src + (size_t)(r0 + r) * C + c0 + c4); const float s = rowscale ? rowscale[r0 + r] : 1.0f;
            tile[r * 65 + c4 + 0] = v.x * s; tile[r * 65 + c4 + 1] = v.y * s; tile[r * 65 + c4 + 2] = v.z * s; tile[r * 65 + c4 + 3] = v.w * s; }
        __syncthreads();
        { const int c = tid >> 3, r8 = (tid & 7) * 8; float v[8];
#pragma unroll
          for (int e = 0; e < 8; ++e) v[e] = tile[(r8 + e) * 65 + c];
          uint4 w; w.x = pk(v[0], v[1]); w.y = pk(v[2], v[3]); w.z = pk(v[4], v[5]); w.w = pk(v[6], v[7]);
          *(uint4*)(dst + (size_t)(c0 + c) * R + r0 + r8) = w; }
    }
}
__device__ void phase_filter(const Params& p, unsigned char* lds) {
    const int tid = threadIdx.x;
    float* Z = (float*)lds; float* H1 = Z + 32 * 33; float* H2 = H1 + 2048; float* H3 = H2 + 2048;
    const float *w1 = p.in[5], *b1 = p.in[6], *f1 = p.in[7], *w2 = p.in[8], *b2 = p.in[9], *f2 = p.in[10], *w3 = p.in[11], *b3 = p.in[12], *f3 = p.in[13], *w4 = p.in[14];
    float* KF = (float*)(p.ws + OFF_KF); float* PS = (float*)(p.ws + OFF_PS);
    const float MIN_DECAY = -15.350567286626973f, MAX_DECAY = -3.0701134573253945f;
    for (int item = blockIdx.x; item < 256; item += gridDim.x) {
        const int j0 = item * 32;
        __syncthreads();
        for (int idx = tid; idx < 32 * 33; idx += 512) { const int row = idx / 33, i = idx % 33, j = j0 + row; float val;
            if (i == 0) val = (float)j * (1.0f / 8191.0f);
            else { const int m = (i - 1) & 15; const float fm = 1e-4f + (float)m * ((15.0f - 1e-4f) / 15.0f); const float wj = (float)j * (6.283185307179586f / 8192.0f); const float xx = wj * fm;
                val = (i <= 16) ? cos_rad(xx) : -sin_rad(xx); }
            Z[idx] = val; }
        __syncthreads();
        { int o = tid & 63; asm volatile("" : "+v"(o)); const int w8 = tid >> 6;
          { float wr[33];
#pragma unroll
            for (int i = 0; i < 33; ++i) wr[i] = w1[i * 64 + o];
            const float bo = b1[o], fo = f1[o];
#pragma unroll 1
            for (int k = 0; k < 4; ++k) { const int row = w8 + 8 * k; float acc = bo;
#pragma unroll
                for (int i = 0; i < 33; ++i) acc += Z[row * 33 + i] * wr[i];
                H1[row * 64 + o] = sin_rad(fo * acc); } }
          __syncthreads();
          { float wr[64];
#pragma unroll
            for (int i = 0; i < 64; ++i) wr[i] = w2[i * 64 + o];
            const float bo = b2[o], fo = f2[o];
#pragma unroll 1
            for (int k = 0; k < 4; ++k) { const int row = w8 + 8 * k; float acc = bo; const float4* h4 = (const float4*)(H1 + row * 64);
#pragma unroll
                for (int i4 = 0; i4 < 16; ++i4) { const float4 hv = h4[i4]; acc += hv.x * wr[4 * i4] + hv.y * wr[4 * i4 + 1] + hv.z * wr[4 * i4 + 2] + hv.w * wr[4 * i4 + 3]; }
                H2[row * 64 + o] = sin_rad(fo * acc); } }
          __syncthreads();
          { float wr[64];
#pragma unroll
            for (int i = 0; i < 64; ++i) wr[i] = w3[i * 64 + o];
            const float bo = b3[o], fo = f3[o];
#pragma unroll 1
            for (int k = 0; k < 4; ++k) { const int row = w8 + 8 * k; float acc = bo; const float4* h4 = (const float4*)(H2 + row * 64);
#pragma unroll
                for (int i4 = 0; i4 < 16; ++i4) { const float4 hv = h4[i4]; acc += hv.x * wr[4 * i4] + hv.y * wr[4 * i4 + 1] + hv.z * wr[4 * i4 + 2] + hv.w * wr[4 * i4 + 3]; }
                H3[o * 32 + row] = sin_rad(fo * acc); } }
          __syncthreads(); }
#pragma unroll 1
        for (int pp = 0; pp < 3; ++pp) {
            const int cp = tid + 512 * pp; float acc[32];
#pragma unroll
            for (int r = 0; r < 32; ++r) acc[r] = 0.f;
#pragma unroll 1
            for (int i0 = 0; i0 < 64; i0 += 16) { float wv[16];
#pragma unroll
                for (int i = 0; i < 16; ++i) wv[i] = w4[(i0 + i) * 1536 + cp];
#pragma unroll
                for (int i = 0; i < 16; ++i) { const float w = wv[i]; const float4* h4 = (const float4*)(H3 + (i0 + i) * 32);
#pragma unroll
                    for (int r4 = 0; r4 < 8; ++r4) { const float4 hv = h4[r4]; acc[4 * r4] += hv.x * w; acc[4 * r4 + 1] += hv.y * w; acc[4 * r4 + 2] += hv.z * w; acc[4 * r4 + 3] += hv.w * w; } }
                __builtin_amdgcn_sched_barrier(0); }
            const bool bwd = cp >= DH; const int c = bwd ? cp - DH : cp;
            const float ad = fabsf(MIN_DECAY + (float)c * ((MAX_DECAY - MIN_DECAY) / 767.0f));
            float asum = 0.f; float* kc = KF + (size_t)c * NFFT;
#pragma unroll
            for (int r = 0; r < 32; ++r) { const int j = j0 + r; const float tj = (float)j * (1.0f / 8191.0f); acc[r] *= __expf(-tj * ad); if (!bwd || j >= 1) asum += fabsf(acc[r]); }
            if (!bwd) {
#pragma unroll
                for (int r4 = 0; r4 < 8; ++r4) *(float4*)(kc + j0 + 4 * r4) = make_float4(acc[4 * r4], acc[4 * r4 + 1], acc[4 * r4 + 2], acc[4 * r4 + 3]);
            } else {
                float* kb = kc + (NFFT - j0 - 32);
                kb[1] = acc[31]; kb[2] = acc[30]; kb[3] = acc[29];
#pragma unroll
                for (int k4 = 1; k4 < 8; ++k4) *(float4*)(kb + 4 * k4) = make_float4(acc[32 - 4 * k4], acc[31 - 4 * k4], acc[30 - 4 * k4], acc[29 - 4 * k4]);
                if (j0 >= 1) kc[NFFT - j0] = acc[0];
            }
            PS[item * 1536 + cp] = asum;
            if (item == 0 && !bwd) kc[SEQ] = 0.f;
        }
    }
}
__device__ void phase0(const Params& p, unsigned char* lds) {
    { float* rq = (float*)(p.ws + OFF_ROWSQ); for (int i = blockIdx.x * 512 + threadIdx.x; i < NTOK; i += gridDim.x * 512) rq[i] = 0.f; }
    const bool filter_first = (blockIdx.x & 1) != 0;
    if (filter_first) { phase_filter(p, lds); __syncthreads(); }
    phase_xn(p);
    transpose_to_bf16(p.in[2], DM, 4608, p.in[1], (bf16_t*)(p.ws + OFF_WT1), (float*)lds);
    transpose_to_bf16(p.in[25], 1536, DM, nullptr, (bf16_t*)(p.ws + OFF_WT2), (float*)lds);
    if (!filter_first) phase_filter(p, lds);
}
__device__ void phase_gemm1(const Params& p, unsigned char* lds) {
    PG8_LAS unsigned char* l3 = (PG8_LAS unsigned char*)lds;
    const bf16_t* XN = (const bf16_t*)(p.ws + OFF_XN); const bf16_t* WT1 = (const bf16_t*)(p.ws + OFF_WT1);
#pragma unroll 1
    for (int pass = 0; pass < 2; ++pass) {
        int ps = pass; asm volatile("" : "+s"(ps));
        pg8::StaticOrder S; pg8::Gemm g; pg8::EpiStoreBf16 E;
        g.A = ps ? XN : WT1; g.Bt = ps ? WT1 + (size_t)2304 * DM : XN; g.M = ps ? NTOK : 2304; g.N = ps ? 2304 : NTOK; g.K = DM;
        E.O = (bf16_t*)(p.ws + (ps ? OFF_P2 : OFF_HYT)); E.ldc = g.N;
        S.init(g.M, g.N, (int)gridDim.x, (int)blockIdx.x);
        pg8::gemm_phase<pg8::EpiStoreBf16, pg8::StaticOrder, false>(l3, g, S, E, nullptr);
        __syncthreads();
    }
}
__device__ void phase_gemm2(const Params& p, unsigned char* lds) {
    PG8_LAS unsigned char* l3 = (PG8_LAS unsigned char*)lds;
    pg8::Gemm g{(const bf16_t*)(p.ws + OFF_YCAT), (const bf16_t*)(p.ws + OFF_WT2), NTOK, DM, 1536};
    pg8::EpiFinal E{p.out, p.in[0], p.in[26], (float*)(p.ws + OFF_ROWSQ), (unsigned*)(p.ws + OFF_CNT)};
    const int G = (int)gridDim.x;
#pragma unroll 1
    for (int L = (int)blockIdx.x; L < 1024; L += G) {
        pg8::OneUnit S;
        if (G == 256) { const int r = L >> 8, c = L & 255, x = c & 7, t = c >> 3; S.pm = 64 * r + x * 8 + (t >> 2); S.pn = t & 3; }
        else { S.pm = L >> 2; S.pn = L & 3; }
        pg8::gemm_phase<pg8::EpiFinal, pg8::OneUnit, false>(l3, g, S, E, nullptr);
        __syncthreads();
    }
}
typedef float v2 __attribute__((ext_vector_type(2)));
__device__ __forceinline__ int phys(int e) { return e + ((e >> 5) << 1); }
__device__ __forceinline__ v2 cmulv(v2 a, v2 b) { v2 t, r;
    asm("v_pk_mul_f32 %0, %1, %2 op_sel:[0,0] op_sel_hi:[0,1]" : "=v"(t) : "v"(a), "v"(b));
    asm("v_pk_fma_f32 %0, %1, %2, %3 op_sel:[1,1,0] op_sel_hi:[1,0,1] neg_lo:[0,1,0]" : "=v"(r) : "v"(a), "v"(b), "v"(t));
    return r; }
template <int SGN> __device__ __forceinline__ void addsub_rot(v2 a, v2 b, v2& p, v2& m) {
    if (SGN < 0) { asm("v_pk_add_f32 %0, %1, %2 op_sel:[0,1] op_sel_hi:[1,0] neg_hi:[0,1]" : "=v"(p) : "v"(a), "v"(b));
                   asm("v_pk_add_f32 %0, %1, %2 op_sel:[0,1] op_sel_hi:[1,0] neg_lo:[0,1]" : "=v"(m) : "v"(a), "v"(b)); }
    else         { asm("v_pk_add_f32 %0, %1, %2 op_sel:[0,1] op_sel_hi:[1,0] neg_lo:[0,1]" : "=v"(p) : "v"(a), "v"(b));
                   asm("v_pk_add_f32 %0, %1, %2 op_sel:[0,1] op_sel_hi:[1,0] neg_hi:[0,1]" : "=v"(m) : "v"(a), "v"(b)); }
}
__device__ __forceinline__ constexpr float c16(int k) { return k == 0 ? 1.0f : k == 1 ? 0.9238795325112867f : k == 2 ? 0.7071067811865476f : k == 3 ? 0.3826834323650898f : k == 4 ? 0.0f : k == 6 ? -0.7071067811865476f : k == 9 ? -0.9238795325112867f : 0.0f; }
__device__ __forceinline__ constexpr float s16(int k) { return k == 0 ? 0.0f : k == 1 ? 0.3826834323650898f : k == 2 ? 0.7071067811865476f : k == 3 ? 0.9238795325112867f : k == 4 ? 1.0f : k == 6 ? 0.7071067811865476f : k == 9 ? -0.3826834323650898f : 0.0f; }
template <int SGN> __device__ __forceinline__ void bfly4(v2& a0, v2& a1, v2& a2, v2& a3) {
    const v2 t0 = a0 + a2, t1 = a0 - a2, t2 = a1 + a3, t3 = a1 - a3;
    a0 = t0 + t2; a2 = t0 - t2; addsub_rot<SGN>(t1, t3, a1, a3);
}
template <int SGN> __device__ __forceinline__ void dft16(v2 (&x)[16]) {
#pragma unroll
    for (int q2 = 0; q2 < 4; ++q2) bfly4<SGN>(x[q2], x[q2 + 4], x[q2 + 8], x[q2 + 12]);
#pragma unroll
    for (int q2 = 1; q2 < 4; ++q2)
#pragma unroll
        for (int r1 = 1; r1 < 4; ++r1) { const int k = q2 * r1; const v2 w = {c16(k), (float)SGN * s16(k)}; x[q2 + 4 * r1] = cmulv(x[q2 + 4 * r1], w); }
#pragma unroll
    for (int r1 = 0; r1 < 4; ++r1) bfly4<SGN>(x[4 * r1], x[4 * r1 + 1], x[4 * r1 + 2], x[4 * r1 + 3]);
}
#define FFT_TW_CHAIN() v2 tw[16]; { const float ang = (float)j * (1.0f / (float)M); const float sn = __builtin_amdgcn_sinf(ang), cs = __builtin_amdgcn_cosf(ang); \
          tw[0] = (v2){1.f, 0.f}; tw[1] = (v2){cs, (float)SGN * sn}; tw[2] = cmulv(tw[1], tw[1]); tw[3] = cmulv(tw[2], tw[1]); tw[4] = cmulv(tw[2], tw[2]); tw[5] = cmulv(tw[4], tw[1]); tw[6] = cmulv(tw[3], tw[3]); tw[7] = cmulv(tw[4], tw[3]); \
          tw[8] = cmulv(tw[4], tw[4]); tw[9] = cmulv(tw[8], tw[1]); tw[10] = cmulv(tw[5], tw[5]); tw[11] = cmulv(tw[8], tw[3]); tw[12] = cmulv(tw[6], tw[6]); tw[13] = cmulv(tw[8], tw[5]); tw[14] = cmulv(tw[7], tw[7]); tw[15] = cmulv(tw[8], tw[7]); }
template <int M, int SGN, int HALF> __device__ __forceinline__ void fft_pass16(v2* z, int tid) {
    constexpr int S = M / 16; constexpr int PS = (S >= 64) ? S + S / 16 : S;
#pragma unroll 1
    for (int it = 0; it < 2; ++it) {
        int t = tid + it * 512; asm volatile("" : "+v"(t)); const int j = t & (S - 1); const int base = (t / S) * M;
        v2* zp = z + phys(base + j);
        v2 x[16];
#pragma unroll
        for (int q = 0; q < 16; ++q) x[q] = (HALF && SGN < 0 && q >= 8) ? (v2){0.f, 0.f} : zp[q * PS];
        const float ang = (float)j * (1.0f / (float)M); const v2 w1 = {__builtin_amdgcn_cosf(ang), (float)SGN * __builtin_amdgcn_sinf(ang)};
        if (SGN > 0) { v2 w = w1;
#pragma unroll
            for (int q = 1; q < 16; ++q) { x[q] = cmulv(x[q], w); if (q < 15) w = cmulv(w, w1); }
            dft16<SGN>(x);
#pragma unroll
            for (int pp = 0; pp < 16; ++pp) { const int r = (pp >> 2) + 4 * (pp & 3); if (HALF && r >= 8) continue; zp[r * PS] = x[pp]; }
        } else {
            dft16<SGN>(x);
            v2 w = w1; zp[0] = x[0];
#pragma unroll
            for (int r = 1; r < 16; ++r) { const int pp = 4 * (r & 3) + (r >> 2); zp[r * PS] = cmulv(x[pp], w); if (r < 15) w = cmulv(w, w1); }
        }
    }
}
__device__ __forceinline__ constexpr float c32(int k) { return k == 0 ? 1.0f : k == 1 ? 0.9807852804032304f : k == 2 ? 0.9238795325112867f : k == 3 ? 0.8314696123025452f : k == 4 ? 0.7071067811865476f : k == 5 ? 0.5555702330196022f : k == 6 ? 0.3826834323650898f : k == 7 ? 0.1950903220161283f : k == 8 ? 0.0f
    : k == 9 ? -0.1950903220161283f : k == 10 ? -0.3826834323650898f : k == 11 ? -0.5555702330196022f : k == 12 ? -0.7071067811865476f : k == 13 ? -0.8314696123025452f : k == 14 ? -0.9238795325112867f : -0.9807852804032304f; }
__device__ __forceinline__ constexpr float s32(int k) { return k == 0 ? 0.0f : k == 1 ? 0.1950903220161283f : k == 2 ? 0.3826834323650898f : k == 3 ? 0.5555702330196022f : k == 4 ? 0.7071067811865476f : k == 5 ? 0.8314696123025452f : k == 6 ? 0.9238795325112867f : k == 7 ? 0.9807852804032304f : k == 8 ? 1.0f
    : k == 9 ? 0.9807852804032304f : k == 10 ? 0.9238795325112867f : k == 11 ? 0.8314696123025452f : k == 12 ? 0.7071067811865476f : k == 13 ? 0.5555702330196022f : k == 14 ? 0.3826834323650898f : 0.1950903220161283f; }
template <int SGN> __device__ __forceinline__ void dft32(v2 (&x)[32]) {
    v2 E[16], O[16];
#pragma unroll
    for (int i = 0; i < 16; ++i) { E[i] = x[2 * i]; O[i] = x[2 * i + 1]; }
    dft16<SGN>(E); dft16<SGN>(O);
#pragma unroll
    for (int k = 0; k < 16; ++k) { const int pp = 4 * (k & 3) + (k >> 2); v2 o = O[pp];
        if (k > 0) { const v2 w = {c32(k), (float)SGN * s32(k)}; o = cmulv(o, w); }
        x[k] = E[pp] + o; x[k + 16] = E[pp] - o; }
}
template <int SGN> __device__ __forceinline__ void fft_pass32(v2* z, int tid) {
    int t = tid; asm volatile("" : "+v"(t)); const int j = t & 31; v2* zp = z + phys((t >> 5) * 1024 + j);
    v2 x[32];
#pragma unroll
    for (int q = 0; q < 32; ++q) x[q] = zp[34 * q];
    const float ang = (float)j * (1.0f / 1024.0f); const v2 w1 = {__builtin_amdgcn_cosf(ang), (float)SGN * __builtin_amdgcn_sinf(ang)};
    if (SGN > 0) { v2 w = w1;
#pragma unroll
        for (int q = 1; q < 32; ++q) { x[q] = cmulv(x[q], w); if (q < 31) w = cmulv(w, w1); }
        dft32<SGN>(x);
#pragma unroll
        for (int q = 0; q < 32; ++q) zp[34 * q] = x[q];
    } else {
        dft32<SGN>(x);
        v2 w = w1; zp[0] = x[0];
#pragma unroll
        for (int r = 1; r < 32; ++r) { zp[34 * r] = cmulv(x[r], w); if (r < 31) w = cmulv(w, w1); }
    }
}
__device__ __forceinline__ void ld32(const v2* z, int tid, v2 (&x)[32]) { const float4* s = (const float4*)(z + phys(32 * tid));
#pragma unroll
    for (int i = 0; i < 16; ++i) { const float4 a = s[i]; x[2 * i] = (v2){a.x, a.y}; x[2 * i + 1] = (v2){a.z, a.w}; } }
__device__ __forceinline__ void st32(v2* z, int tid, const v2 (&x)[32]) { float4* s = (float4*)(z + phys(32 * tid));
#pragma unroll
    for (int i = 0; i < 16; ++i) s[i] = make_float4(x[2 * i].x, x[2 * i].y, x[2 * i + 1].x, x[2 * i + 1].y); }
struct In6 { uint2 w; unsigned halo; };
__device__ __forceinline__ In6 ld6(const bf16_t* seq, int l4) { In6 r; r.w = *(const uint2*)(seq + l4); const unsigned lo = l4 > 0 ? seq[l4 - 1] : 0u, hi = (l4 + 4 < SEQ) ? seq[l4 + 4] : 0u; r.halo = lo | (hi << 16); return r; }
__device__ __forceinline__ void conv3(const In6& in, float w0, float w1, float w2, float bb, float (&o)[4]) {
    const float i0 = bflo(in.halo), i1 = bflo(in.w.x), i2 = bfhi(in.w.x), i3 = bflo(in.w.y), i4 = bfhi(in.w.y), i5 = bfhi(in.halo);
    o[0] = bb + w0 * i0 + w1 * i1 + w2 * i2; o[1] = bb + w0 * i1 + w1 * i2 + w2 * i3; o[2] = bb + w0 * i2 + w1 * i3 + w2 * i4; o[3] = bb + w0 * i3 + w1 * i4 + w2 * i5;
}
__device__ void hyena_unit(const Params& p, unsigned char* lds, int c, int pr_lo, int pr_hi) {
    int tid = threadIdx.x; asm volatile("" : "+v"(tid)); const int lane = tid & 63, wid = tid >> 6;
    v2* z = (v2*)lds; float* red = (float*)(lds + ZPHYS * 8);
    const bf16_t* HYT = (const bf16_t*)(p.ws + OFF_HYT); bf16_t* YHT = (bf16_t*)(p.ws + OFF_YHT);
    const float* PS = (const float*)(p.ws + OFF_PS); const float* kf = (const float*)(p.ws + OFF_KF) + (size_t)c * NFFT;
    __syncthreads();
    { float part = 0.f; if (tid < 256) part = PS[tid * 1536 + c] + PS[tid * 1536 + DH + c];
      part = wave_sum(part); if (lane == 0 && wid < 4) red[wid] = part; }
    { float4 kv[8];
#pragma unroll
      for (int it = 0; it < 8; ++it) kv[it] = *(const float4*)(kf + (tid + 512 * it) * 4);
      __syncthreads();
      const float scale = 1.0f / ((red[0] + red[1] + red[2] + red[3] + 1e-6f) * (float)NFFT);
#pragma unroll
      for (int it = 0; it < 8; ++it) { const int e4 = (tid + 512 * it) * 4; float4* d = (float4*)(z + phys(e4));
          d[0] = make_float4(kv[it].x * scale, 0.f, kv[it].y * scale, 0.f); d[1] = make_float4(kv[it].z * scale, 0.f, kv[it].w * scale, 0.f); } }
    __syncthreads();
    unsigned pw;
    { const int sq = tid >> 7; const bf16_t* sp = HYT + (size_t)((sq & 1) ? 2 * DH + c : c) * NTOK + (size_t)(2 * pr_lo + (sq >> 1)) * SEQ; pw = *(const unsigned*)((const char*)sp + (tid & 127) * 128); }
    fft_pass16<16384, -1, 0>(z, tid); __syncthreads(); fft_pass32<-1>(z, tid); __syncthreads();
    if (pw == 0x9e3779b9u) red[9] = 1.f;
    v2 kh[32];
    ld32(z, tid, kh); dft32<-1>(kh);
    const float* cw = p.in[3]; const float* cb = p.in[4];
    const float wv0 = cw[c], wv1 = cw[2304 + c], wv2 = cw[4608 + c], bv = cb[c];
    const float wa0 = cw[DH + c], wa1 = cw[2304 + DH + c], wa2 = cw[4608 + DH + c], ba = cb[DH + c];
    const float wb0 = cw[2 * DH + c], wb1 = cw[2304 + 2 * DH + c], wb2 = cw[4608 + 2 * DH + c], bbq = cb[2 * DH + c];
    const float dskip = p.in[15][c];
    const bf16_t* sv = HYT + (size_t)c * NTOK; const bf16_t* sx0 = HYT + (size_t)(DH + c) * NTOK; const bf16_t* sx1 = HYT + (size_t)(2 * DH + c) * NTOK;
#pragma unroll 1
    for (int pr = pr_lo; pr < pr_hi; ++pr) {
        const size_t o0 = (size_t)(2 * pr) * SEQ, o1 = o0 + SEQ;
        int tl = tid; asm volatile("" : "+v"(tl));
        unsigned uu[16];
        __syncthreads();
#pragma unroll
        for (int hh = 0; hh < 2; ++hh) { In6 a[2], b[2], cc[2], d[2];
#pragma unroll
          for (int i2 = 0; i2 < 2; ++i2) { const int it = 2 * hh + i2; const int l4 = (tl + 512 * it) * 4; a[i2] = ld6(sv + o0, l4); b[i2] = ld6(sx1 + o0, l4); cc[i2] = ld6(sv + o1, l4); d[i2] = ld6(sx1 + o1, l4); }
#pragma unroll
          for (int i2 = 0; i2 < 2; ++i2) { const int it = 2 * hh + i2; const int l4 = (tl + 512 * it) * 4; float v0[4], x10[4], v1[4], x11[4];
              conv3(a[i2], wv0, wv1, wv2, bv, v0); conv3(b[i2], wb0, wb1, wb2, bbq, x10); conv3(cc[i2], wv0, wv1, wv2, bv, v1); conv3(d[i2], wb0, wb1, wb2, bbq, x11);
#pragma unroll
              for (int s = 0; s < 4; ++s) { v0[s] *= x10[s]; v1[s] *= x11[s]; uu[4 * it + s] = pk(v0[s], v1[s]); }
              float4* dd = (float4*)(z + phys(l4));
              dd[0] = make_float4(v0[0], v1[0], v0[1], v1[1]); dd[1] = make_float4(v0[2], v1[2], v0[3], v1[3]); }
          __builtin_amdgcn_sched_barrier(0); }
        __syncthreads();
        fft_pass16<16384, -1, 1>(z, tid); __syncthreads(); fft_pass32<-1>(z, tid); __syncthreads();
        { v2 x[32]; ld32(z, tl, x); dft32<-1>(x);
#pragma unroll
          for (int r = 0; r < 32; ++r) x[r] = cmulv(x[r], kh[r]);
          dft32<1>(x); st32(z, tl, x); }
        __syncthreads();
        unsigned pf0, pf1;
        { const size_t on = (pr + 1 < pr_hi) ? o0 + 2 * SEQ : o0; const int sq = tid >> 7;
          const bf16_t* sp = ((sq & 1) ? sx1 : sv) + on + (sq >> 1) * SEQ; pf0 = *(const unsigned*)((const char*)sp + (tid & 127) * 128);
          const bf16_t* sp2 = sx0 + o0 + (sq & 1) * SEQ; pf1 = *(const unsigned*)((const char*)sp2 + (tid & 127) * 128); }
        fft_pass32<1>(z, tid); __syncthreads();
        fft_pass16<16384, 1, 1>(z, tid);
        In6 ea[4], eb[4];
#pragma unroll
        for (int it = 0; it < 4; ++it) { const int l4 = (tl + 512 * it) * 4; ea[it] = ld6(sx0 + o0, l4); eb[it] = ld6(sx0 + o1, l4); }
        __syncthreads();
#pragma unroll
        for (int it = 0; it < 4; ++it) { const int l4 = (tl + 512 * it) * 4; float x00[4], x01[4];
            conv3(ea[it], wa0, wa1, wa2, ba, x00); conv3(eb[it], wa0, wa1, wa2, ba, x01);
            const float4* s = (const float4*)(z + phys(l4)); const float4 a = s[0], b = s[1];
            const float cv0[4] = {a.x, a.z, b.x, b.z}, cv1[4] = {a.y, a.w, b.y, b.w};
            float y0[4], y1[4];
#pragma unroll
            for (int s4 = 0; s4 < 4; ++s4) { y0[s4] = x00[s4] * (cv0[s4] + dskip * bflo(uu[4 * it + s4])); y1[s4] = x01[s4] * (cv1[s4] + dskip * bfhi(uu[4 * it + s4])); }
            uint2 w0; w0.x = pk(y0[0], y0[1]); w0.y = pk(y0[2], y0[3]); uint2 w1; w1.x = pk(y1[0], y1[1]); w1.y = pk(y1[2], y1[3]);
            *(uint2*)(YHT + (size_t)c * NTOK + o0 + l4) = w0; *(uint2*)(YHT + (size_t)c * NTOK + o1 + l4) = w1; }
        if ((pf0 ^ pf1) == 0x9e3779b9u) red[8] = 1.f;
    }
}
__device__ void lru_unit(const Params& p, unsigned char* lds, int unit) {
    int tid = threadIdx.x; asm volatile("" : "+v"(tid)); const int lane = tid & 63, wid = __builtin_amdgcn_readfirstlane(tid >> 6);
    const int dir = unit / 96, rem = unit % 96, b = rem / 12, h = rem % 12;
    bf16_t* INs = (bf16_t*)lds + wid * (20 * 64);
    bf16_t* XB = (bf16_t*)(lds + 20480);
    float* AA = (float*)(lds + 38912);
    float* BB = (float*)(lds + 73728);
    float2* CAR = (float2*)(lds + 108544);
    float* HC = (float*)(lds + 116736);
    uint4* WB = (uint4*)(lds + 117248);
    float* CWL = (float*)(lds + 133632);
    const bf16_t* src = (const bf16_t*)(p.ws + OFF_P2) + (size_t)b * SEQ * 2304 + DH + h * 64;
    bf16_t* dst = (bf16_t*)(p.ws + (dir ? OFF_HB : OFF_HF)) + (size_t)b * SEQ * DH + h * 64;
    const float* wa = p.in[18] + (size_t)(dir * 12 + h) * 4096; const float* wx = p.in[20] + (size_t)(dir * 12 + h) * 4096;
    __syncthreads();
    for (int entry = tid; entry < 1024; entry += 512) { const int f = entry >> 6, ln = entry & 63, g = f >> 3, ct = (f >> 1) & 3, ks = f & 1; const int k0 = 32 * ks + 8 * (ln >> 4), col = 16 * ct + (ln & 15);
        const float* W = g ? wx : wa; float v[8];
#pragma unroll
        for (int e = 0; e < 8; ++e) v[e] = -1.4426950408889634f * W[(k0 + e) * 64 + col];
        uint4 w; w.x = pk(v[0], v[1]); w.y = pk(v[2], v[3]); w.z = pk(v[4], v[5]); w.w = pk(v[6], v[7]); WB[entry] = w; }
    if (tid < 128) HC[tid] = 0.f;
    if (tid < 320) { const int k = tid >> 6, ch = h * 64 + (tid & 63); CWL[tid] = (k < 4) ? p.in[16][k * DH + ch] : p.in[17][ch]; }
    const int oct = lane & 7, rl0 = lane >> 3;
    const int q = dir ? 7 - wid : wid;
    float gba[4], gbx[4], sp8[4];
#pragma unroll
    for (int ct = 0; ct < 4; ++ct) { const int ch = dir * DH + h * 64 + 16 * ct + (lane & 15); gba[ct] = -1.4426950408889634f * p.in[19][ch]; gbx[ct] = -1.4426950408889634f * p.in[21][ch];
        const float e = __expf(-p.in[22][ch]); const float sp = (e < 0.02f) ? e * (1.0f - e * (0.5f - e * (1.0f / 3.0f))) : __logf(1.0f + e); sp8[ct] = 8.0f * 1.4426950408889634f * sp; }
    uint4 R[3];
#define LRU_ISSUE(l0v) { _Pragma("unroll") for (int i = 0; i < 3; ++i) { const int item = lane + 64 * i, r = item >> 3, o = item & 7, l = (l0v) - 1 + 16 * wid + r; const bool ok = (item < 152) && l >= 0 && l < SEQ; \
        R[i] = ok ? *(const uint4*)(src + (size_t)l * 2304 + o * 8) : make_uint4(0u, 0u, 0u, 0u); } }
    LRU_ISSUE(dir ? SEQ - 128 : 0)
    __syncthreads();
    float cwr[5][8];
#pragma unroll
    for (int k = 0; k < 5; ++k) { const float4 c0 = *(const float4*)(CWL + k * 64 + oct * 8), c1 = *(const float4*)(CWL + k * 64 + oct * 8 + 4);
        cwr[k][0] = c0.x; cwr[k][1] = c0.y; cwr[k][2] = c0.z; cwr[k][3] = c0.w; cwr[k][4] = c1.x; cwr[k][5] = c1.y; cwr[k][6] = c1.z; cwr[k][7] = c1.w; }
#pragma unroll 1
    for (int T = 0; T < 64; ++T) {
        const int l0 = dir ? SEQ - 128 * (T + 1) : 128 * T;
#pragma unroll
        for (int i = 0; i < 3; ++i) { const int item = lane + 64 * i; if (item < 160) *(uint4*)(INs + (item >> 3) * 64 + (item & 7) * 8) = R[i]; }
        asm volatile("" ::: "memory");
        if (T + 1 < 64) LRU_ISSUE(dir ? SEQ - 128 * (T + 2) : 128 * (T + 1))
#pragma unroll
        for (int i = 0; i < 2; ++i) { const int rl = rl0 + 8 * i; float acc[8];
#pragma unroll
            for (int e = 0; e < 8; ++e) acc[e] = cwr[4][e];
#pragma unroll
            for (int k = 0; k < 4; ++k) { const uint4 w = *(const uint4*)(INs + (rl + k) * 64 + oct * 8);
                acc[0] += cwr[k][0] * bflo(w.x); acc[1] += cwr[k][1] * bfhi(w.x); acc[2] += cwr[k][2] * bflo(w.y); acc[3] += cwr[k][3] * bfhi(w.y);
                acc[4] += cwr[k][4] * bflo(w.z); acc[5] += cwr[k][5] * bfhi(w.z); acc[6] += cwr[k][6] * bflo(w.w); acc[7] += cwr[k][7] * bfhi(w.w); }
            uint4 o; o.x = pk(acc[0], acc[1]); o.y = pk(acc[2], acc[3]); o.z = pk(acc[4], acc[5]); o.w = pk(acc[6], acc[7]);
            *(uint4*)(XB + (16 * wid + rl) * 72 + oct * 8) = o; }
        asm volatile("" ::: "memory");
        { const int rowA = 16 * wid + (lane & 15);
          const bf16x8_t a0 = *(const bf16x8_t*)(XB + rowA * 72 + 8 * (lane >> 4)), a1 = *(const bf16x8_t*)(XB + rowA * 72 + 32 + 8 * (lane >> 4));
          const int firstrow = dir ? 127 : 0;
#pragma unroll
          for (int ct = 0; ct < 4; ++ct) {
              f32x4_t accA = {gba[ct], gba[ct], gba[ct], gba[ct]}, accX = {gbx[ct], gbx[ct], gbx[ct], gbx[ct]};
              const uint4 b0 = WB[((0 * 4 + ct) * 2 + 0) * 64 + lane], b1 = WB[((0 * 4 + ct) * 2 + 1) * 64 + lane], b2 = WB[((1 * 4 + ct) * 2 + 0) * 64 + lane], b3 = WB[((1 * 4 + ct) * 2 + 1) * 64 + lane];
              accA = __builtin_amdgcn_mfma_f32_16x16x32_bf16(a0, __builtin_bit_cast(bf16x8_t, b0), accA, 0, 0, 0);
              accA = __builtin_amdgcn_mfma_f32_16x16x32_bf16(a1, __builtin_bit_cast(bf16x8_t, b1), accA, 0, 0, 0);
              accX = __builtin_amdgcn_mfma_f32_16x16x32_bf16(a0, __builtin_bit_cast(bf16x8_t, b2), accX, 0, 0, 0);
              accX = __builtin_amdgcn_mfma_f32_16x16x32_bf16(a1, __builtin_bit_cast(bf16x8_t, b3), accX, 0, 0, 0);
              const int ch = 16 * ct + (lane & 15);
#pragma unroll
              for (int j = 0; j < 4; ++j) { const int row = 16 * wid + 4 * (lane >> 4) + j;
                  const float r = __builtin_amdgcn_rcpf(1.0f + __builtin_amdgcn_exp2f(accA[j])), ig = __builtin_amdgcn_rcpf(1.0f + __builtin_amdgcn_exp2f(accX[j]));
                  const float a = __builtin_amdgcn_exp2f(-sp8[ct] * r); float mult = __builtin_amdgcn_sqrtf(fmaxf(1.0f - a * a, 0.f));
                  if (T == 0 && row == firstrow) mult = 1.0f;
                  const float xbv = bf2f(XB[row * 72 + ch]);
                  AA[row * 68 + ch] = a; BB[row * 68 + ch] = mult * ig * xbv; } } }
        asm volatile("" ::: "memory");
        { float av[16], bv[16]; float P = 1.f, H = 0.f;
#pragma unroll
          for (int s = 0; s < 16; ++s) { const int row = 16 * wid + (dir ? 15 - s : s); av[s] = AA[row * 68 + lane]; bv[s] = BB[row * 68 + lane]; H = av[s] * H + bv[s]; P *= av[s]; }
          CAR[((T & 1) * 8 + q) * 64 + lane] = make_float2(P, H);
          __syncthreads();
          float hin = HC[(T & 1) * 64 + lane];
          for (int s2 = 0; s2 < q; ++s2) { const float2 c2 = CAR[((T & 1) * 8 + s2) * 64 + lane]; hin = c2.x * hin + c2.y; }
#pragma unroll
          for (int s = 0; s < 16; ++s) { const int row = 16 * wid + (dir ? 15 - s : s); hin = av[s] * hin + bv[s]; dst[(size_t)(l0 + row) * DH + lane] = (bf16_t)(pk(hin, hin) & 0xffffu); }
          if (q == 7) HC[((T + 1) & 1) * 64 + lane] = hin; }
    }
#undef LRU_ISSUE
}
__device__ void phase_mix(const Params& p, unsigned char* lds, int which, int skip = 0) {
    unsigned* ctr = (unsigned*)(p.ws + OFF_CTL) + which; volatile int* slot = (volatile int*)(lds + LDS_BYTES - 16);
    for (;;) {
        __syncthreads();
        if (threadIdx.x == 0) *slot = (int)atomicAdd(ctr, 1u);
        __syncthreads();
        const int u = __builtin_amdgcn_readfirstlane(*slot);
        if (u >= N_LRU_UNITS + N_HY_FULL + 2 * (N_HY_UNITS - N_HY_FULL)) break;
        if (u < N_LRU_UNITS) { if (skip != 1) lru_unit(p, lds, u); }
        else if (skip != 2) { const int v = u - N_LRU_UNITS;
            if (v < N_HY_FULL) hyena_unit(p, lds, v, 0, 4);
            else { const int w = v - N_HY_FULL; hyena_unit(p, lds, N_HY_FULL + (w >> 1), (w & 1) * 2, (w & 1) * 2 + 2); } }
    }
}
__device__ void phase_ycat(const Params& p, unsigned char* lds) {
    const int tid = threadIdx.x, lane = tid & 63, wid = tid >> 6;
    unsigned* T = (unsigned*)lds; const unsigned short* Th = (const unsigned short*)lds;
    const bf16_t* YHT = (const bf16_t*)(p.ws + OFF_YHT); const bf16_t* P2 = (const bf16_t*)(p.ws + OFF_P2);
    const bf16_t* HF = (const bf16_t*)(p.ws + OFF_HF); const bf16_t* HB = (const bf16_t*)(p.ws + OFF_HB); bf16_t* YC = (bf16_t*)(p.ws + OFF_YCAT);
    float hg[12], lg[12];
#pragma unroll
    for (int m = 0; m < 6; ++m) { hg[2 * m] = p.in[23][2 * lane + 128 * m]; hg[2 * m + 1] = p.in[23][2 * lane + 128 * m + 1]; }
#pragma unroll
    for (int m = 0; m < 3; ++m)
#pragma unroll
        for (int e = 0; e < 4; ++e) lg[4 * m + e] = p.in[24][4 * lane + 256 * m + e];
    uint4 yt[12];
    { const int tok0 = blockIdx.x * 64;
#pragma unroll
      for (int i = 0; i < 12; ++i) { const int idx = tid + 512 * i, c = idx >> 3, seg = idx & 7; yt[i] = (blockIdx.x < NTOK / 64) ? *(const uint4*)(YHT + (size_t)c * NTOK + tok0 + seg * 8) : make_uint4(0u, 0u, 0u, 0u); } }
    for (int tile = blockIdx.x; tile < NTOK / 64; tile += gridDim.x) {
        const int tok0 = tile * 64;
        __syncthreads();
#pragma unroll
        for (int i = 0; i < 12; ++i) { const int idx = tid + 512 * i, c = idx >> 3, seg = idx & 7; unsigned* d = T + c * 33 + seg * 4; d[0] = yt[i].x; d[1] = yt[i].y; d[2] = yt[i].z; d[3] = yt[i].w; }
        __syncthreads();
        { const int ntile = tile + gridDim.x; const int tokn = (ntile < NTOK / 64 ? ntile : tile) * 64;
#pragma unroll
          for (int i = 0; i < 12; ++i) { const int idx = tid + 512 * i, c = idx >> 3, seg = idx & 7; yt[i] = *(const uint4*)(YHT + (size_t)c * NTOK + tokn + seg * 8); } }
        unsigned gh[2][6]; uint2 hf[2][3], hb[2][3], gl[2][3];
#define YC_ISSUE(slot, ii) { const size_t tk = (size_t)tok0 + 8 * wid + (ii); \
            _Pragma("unroll") for (int m = 0; m < 6; ++m) gh[slot][m] = *(const unsigned*)(P2 + tk * 2304 + 2 * lane + 128 * m); \
            _Pragma("unroll") for (int m = 0; m < 3; ++m) { const int c = 4 * lane + 256 * m; hf[slot][m] = *(const uint2*)(HF + tk * DH + c); hb[slot][m] = *(const uint2*)(HB + tk * DH + c); gl[slot][m] = *(const uint2*)(P2 + tk * 2304 + 1536 + c); } }
        YC_ISSUE(0, 0)
#pragma unroll
        for (int i = 0; i < 8; ++i) { const int t = 8 * wid + i; const size_t tok = (size_t)tok0 + t; const int cs = i & 1, ns = cs ^ 1;
            if (i < 7) YC_ISSUE(ns, i + 1)
            float y[12]; float ss = 0.f;
#pragma unroll
            for (int m = 0; m < 6; ++m) { const int c = 2 * lane + 128 * m; y[2 * m] = bf2f(Th[c * 66 + t]); y[2 * m + 1] = bf2f(Th[(c + 1) * 66 + t]); ss += y[2 * m] * y[2 * m] + y[2 * m + 1] * y[2 * m + 1]; }
            ss = wave_sum(ss); const float rs = rsqrtf(ss * (1.0f / DH) + 1e-6f);
#pragma unroll
            for (int m = 0; m < 6; ++m) { const int c = 2 * lane + 128 * m; const unsigned gw = gh[cs][m]; const float g0 = bflo(gw), g1 = bfhi(gw);
                const float o0 = y[2 * m] * rs * hg[2 * m] * (g0 * sigm(g0)), o1 = y[2 * m + 1] * rs * hg[2 * m + 1] * (g1 * sigm(g1));
                *(unsigned*)(YC + tok * 1536 + c) = pk(o0, o1); }
            float q[12]; float s2 = 0.f;
#pragma unroll
            for (int m = 0; m < 3; ++m) { const uint2 f = hf[cs][m], bq = hb[cs][m];
                q[4 * m] = bflo(f.x) + bflo(bq.x); q[4 * m + 1] = bfhi(f.x) + bfhi(bq.x); q[4 * m + 2] = bflo(f.y) + bflo(bq.y); q[4 * m + 3] = bfhi(f.y) + bfhi(bq.y);
                s2 += q[4 * m] * q[4 * m] + q[4 * m + 1] * q[4 * m + 1] + q[4 * m + 2] * q[4 * m + 2] + q[4 * m + 3] * q[4 * m + 3]; }
            s2 = wave_sum(s2); const float rs2 = rsqrtf(s2 * (1.0f / DH) + 1e-6f);
#pragma unroll
            for (int m = 0; m < 3; ++m) { const int c = 4 * lane + 256 * m; const uint2 gw = gl[cs][m];
                const float g0 = bflo(gw.x), g1 = bfhi(gw.x), g2 = bflo(gw.y), g3 = bfhi(gw.y);
                uint2 o; o.x = pk(q[4 * m] * rs2 * lg[4 * m] * (g0 * sigm(g0)), q[4 * m + 1] * rs2 * lg[4 * m + 1] * (g1 * sigm(g1)));
                o.y = pk(q[4 * m + 2] * rs2 * lg[4 * m + 2] * (g2 * sigm(g2)), q[4 * m + 3] * rs2 * lg[4 * m + 3] * (g3 * sigm(g3)));
                *(uint2*)(YC + tok * 1536 + DH + c) = o; }
        }
#undef YC_ISSUE
    }
}
__device__ void phase_final(const Params& p) {
    const int tid = threadIdx.x, lane = tid & 63, wid = tid >> 6;
    const float4* g4 = (const float4*)p.in[26]; float4 gv[4];
#pragma unroll
    for (int i = 0; i < 4; ++i) gv[i] = g4[i * 64 + lane];
    for (int row = blockIdx.x * 8 + wid; row < NTOK; row += gridDim.x * 8) {
        float4* src = (float4*)(p.out + (size_t)row * DM);
        float4 v[4]; float ss = 0.f;
#pragma unroll
        for (int i = 0; i < 4; ++i) { v[i] = src[i * 64 + lane]; ss += v[i].x * v[i].x + v[i].y * v[i].y + v[i].z * v[i].z + v[i].w * v[i].w; }
        ss = wave_sum(ss);
        const float rs = rsqrtf(ss * (1.0f / DM) + 1e-6f);
#pragma unroll
        for (int i = 0; i < 4; ++i) src[i * 64 + lane] = make_float4(v[i].x * rs * gv[i].x, v[i].y * rs * gv[i].y, v[i].z * rs * gv[i].z, v[i].w * rs * gv[i].w);
    }
}

#define XB_TMO      128
#define XB_XCNT(j)  (256  + 64 * (j))
#define XB_XSUB(j)  (1280 + 64 * (j))
#define XB_XGEN(j)  (2304 + 64 * (j))
#define XB_TOP      3328
#define XB_TOPGEN   3392
#define XCD_BAR_WORDS 3456
#define XB_SPIN_CAP (1u << 18)
#define LAS __attribute__((address_space(3)))

__device__ __forceinline__ unsigned xb_ld(unsigned* p)              { return __hip_atomic_load(p, __ATOMIC_RELAXED, __HIP_MEMORY_SCOPE_AGENT); }
__device__ __forceinline__ unsigned xb_add(unsigned* p, unsigned v) { return __hip_atomic_fetch_add(p, v, __ATOMIC_RELAXED, __HIP_MEMORY_SCOPE_AGENT); }
__device__ __forceinline__ unsigned xb_xcc_id() { return (unsigned)__builtin_amdgcn_s_getreg((3 << 11) | 20) & 0xFu; }
#define XB_SPIN(cond, bar) do { unsigned _sp = 0; while (cond) { __builtin_amdgcn_s_sleep(1); \
    if ((++_sp & 255u) == 0u) { if (xb_ld(&(bar)[XB_TMO])) break; if (_sp > XB_SPIN_CAP) { atomicAdd(&(bar)[XB_TMO], 1u); break; } } } } while (0)

struct XcdBarrier {
    unsigned* bar; unsigned x;
    volatile LAS unsigned* st;
};

__device__ __forceinline__ XcdBarrier xcd_barrier_post(unsigned* bar, volatile LAS unsigned* st) {
    XcdBarrier b; b.bar = bar; b.x = xb_xcc_id(); b.st = st;
    if (threadIdx.x == 0) (void)xb_add(&bar[XB_XCNT(b.x)], 1u);
    return b;
}
__device__ __forceinline__ void xcd_barrier_complete(unsigned* bar, unsigned x, unsigned& nloc, unsigned& nx) {
    const unsigned G = gridDim.x * gridDim.y * gridDim.z;
    unsigned sum, cnt, mine, sp = 0u;
    for (;;) {
        sum = 0u; cnt = 0u; mine = 0u;
#pragma unroll
        for (unsigned j = 0; j < 16; ++j) { const unsigned c = xb_ld(&bar[XB_XCNT(j)]); sum += c; cnt += (c > 0u) ? 1u : 0u; mine = (j == x) ? c : mine; }
        if (sum == G) break;
        __builtin_amdgcn_s_sleep(1);
        if ((++sp & 255u) == 0u) { if (xb_ld(&bar[XB_TMO])) break; if (sp > XB_SPIN_CAP) { atomicAdd(&bar[XB_TMO], 1u); break; } }
    }
    nloc = mine > 0u ? mine : 1u; nx = cnt > 0u ? cnt : 1u;
}

__device__ __forceinline__ void xcd_barrier(const XcdBarrier& b) {
    asm volatile("s_waitcnt vmcnt(0)" ::: "memory");
    __syncthreads();
    if (threadIdx.x == 0) {
        unsigned* bar = b.bar;
        __builtin_amdgcn_s_waitcnt(0);
        unsigned nloc = b.st[0], nx = b.st[1];
        if (nloc == 0u) { xcd_barrier_complete(bar, b.x, nloc, nx); b.st[0] = nloc; b.st[1] = nx; }
        const unsigned old = xb_add(&bar[XB_XSUB(b.x)], 1u);
        const unsigned gen = old / nloc;
        if (old + 1u == (gen + 1u) * nloc) {
            __builtin_amdgcn_fence(__ATOMIC_RELEASE, "agent");
            asm volatile("s_waitcnt vmcnt(0)" ::: "memory");
            const unsigned og = xb_add(&bar[XB_TOP], 1u);
            const unsigned tg = og / nx;
            if (og + 1u == (tg + 1u) * nx) xb_add(&bar[XB_TOPGEN], 1u);
            else XB_SPIN(xb_ld(&bar[XB_TOPGEN]) == tg, bar);
            __builtin_amdgcn_fence(__ATOMIC_ACQUIRE, "agent");
            xb_add(&bar[XB_XGEN(b.x)], 1u);
            asm volatile("s_waitcnt vmcnt(0)" ::: "memory");
        } else {
            XB_SPIN(xb_ld(&bar[XB_XGEN(b.x)]) == gen, bar);
            __builtin_amdgcn_fence(__ATOMIC_ACQUIRE, "agent");
            asm volatile("s_waitcnt vmcnt(0)" ::: "memory");
        }
    }
    __syncthreads();
}

constexpr int N_PHASES = 5;
__global__ void __launch_bounds__(512) hymba_fwd(Params p) {
    extern __shared__ __attribute__((aligned(16))) unsigned char lds[];
    cg::grid_group grid = cg::this_grid();
#ifndef ONLY_PHASE
#define ONLY_PHASE -1
#endif
#define PH_ON(n) (ONLY_PHASE < 0 || ONLY_PHASE == (n))
#ifndef DUP_SKIP
#define DUP_SKIP 0
#endif
#ifndef DUP_PHASE
#define DUP_PHASE -1
#endif
    const int lo = p.ph_lo, hi = p.ph_hi;
    volatile LAS unsigned* xst = (volatile LAS unsigned*)((LAS unsigned char*)lds + (LDS_BYTES - 32));
    if (threadIdx.x == 0) { xst[0] = 0u; xst[1] = 0u; }
    __syncthreads();
    const XcdBarrier xb = xcd_barrier_post((unsigned*)(p.ws + OFF_XBAR), xst);
    if (hi > 1000) grid.sync();
    if (lo <= 0 && 0 < hi) { if (PH_ON(0)) phase0(p, lds); if (DUP_PHASE == 0) { grid.sync(); phase0(p, lds); } }
    if (lo <= 1 && 1 < hi) { if (lo < 1) xcd_barrier(xb); if (PH_ON(1)) phase_gemm1(p, lds); if (DUP_PHASE == 1) { grid.sync(); phase_gemm1(p, lds); } }
    if (lo <= 2 && 2 < hi) { if (lo < 2) xcd_barrier(xb); if (PH_ON(2)) phase_mix(p, lds, 0, MIX_SEL); if (DUP_PHASE == 2) { grid.sync(); phase_mix(p, lds, 1, DUP_SKIP); } }
    if (lo <= 3 && 3 < hi) { if (lo < 3) xcd_barrier(xb); if (PH_ON(3)) phase_ycat(p, lds); if (DUP_PHASE == 3) { grid.sync(); phase_ycat(p, lds); } }
    if (lo <= 4 && 4 < hi) { if (lo < 4) xcd_barrier(xb); if (PH_ON(4)) phase_gemm2(p, lds); if (DUP_PHASE == 4) { grid.sync(); phase_gemm2(p, lds); } }
}
extern "C" void kernel_launch(void* const* d_in, const int* in_sizes, int n_in, void* d_out, int out_size, void* d_ws, size_t ws_size, hipStream_t stream) {
    static int grid = 0;
    if (grid == 0) {
        if (n_in != 27 || ws_size < WS_END) { fprintf(stderr, "kernel_launch: expected 27 inputs and >= %zu bytes of workspace (got %d, %zu)\n", (size_t)WS_END, n_in, ws_size); grid = -1; return; }
        int dev = 0, cus = 0, per_cu = 0;
        hipGetDevice(&dev); hipDeviceGetAttribute(&cus, hipDeviceAttributeMultiprocessorCount, dev);
        if (hipFuncSetAttribute((const void*)hymba_fwd, hipFuncAttributeMaxDynamicSharedMemorySize, LDS_BYTES) != hipSuccess) { fprintf(stderr, "kernel_launch: hipFuncSetAttribute failed\n"); grid = -1; return; }
        if (hipOccupancyMaxActiveBlocksPerMultiprocessor(&per_cu, (const void*)hymba_fwd, 512, LDS_BYTES) != hipSuccess || per_cu < 1) { fprintf(stderr, "kernel_launch: occupancy query failed (%d)\n", per_cu); (void)hipGetLastError(); grid = -1; return; }
        grid = cus * per_cu; if (grid > 256) grid = 256; grid &= ~3;
    }
    if (grid < 0) return;
    hipMemsetAsync((char*)d_ws + OFF_CTL, 0, 32768, stream);
    Params p{};
    for (int i = 0; i < 27; ++i) p.in[i] = (const float*)d_in[i];
    p.out = (float*)d_out; p.ws = (unsigned char*)d_ws;
    const int per = (N_PHASES + MK_N_LAUNCHES - 1) / MK_N_LAUNCHES;
    for (int lo = 0; lo < N_PHASES; lo += per) {
        p.ph_lo = lo; p.ph_hi = lo + per < N_PHASES ? lo + per : N_PHASES;
        void* args[] = {&p};
        const hipError_t e = hipLaunchCooperativeKernel((const void*)hymba_fwd, dim3(grid), dim3(512), args, LDS_BYTES, stream);
        if (e != hipSuccess) { fprintf(stderr, "kernel_launch: cooperative launch failed: %s (grid %d)\n", hipGetErrorString(e), grid); break; }
    }
}
```

```cpp
#include <hip/hip_runtime.h>
#include <hip/hip_cooperative_groups.h>
#include <cstdio>
namespace cg = cooperative_groups;
#ifndef MK_N_LAUNCHES
#define MK_N_LAUNCHES 1
#endif
namespace pg8 {
#define PG8_LAS __attribute__((address_space(3)))
typedef unsigned short bf16_t;
typedef short bf16x8 __attribute__((ext_vector_type(8)));
typedef float f32x4 __attribute__((ext_vector_type(4)));
typedef unsigned u32x4 __attribute__((ext_vector_type(4)));
constexpr int BM = 256, BK = 64, HALF = 128, HTB = HALF * BK * 2  , STAGE_BYTES = 8 * HTB, NXCD = 8, WGM = 8;

__host__ __device__ __forceinline__ int lds_byte(int r, int c) { const int st = (r >> 4) * 2 + (c >> 5), rr = r & 15, cc = c & 31, ob = rr * 64 + cc * 2; return st * 1024 + (ob ^ (((ob >> 9) & 1) << 5)); }
__host__ __device__ __forceinline__ void stage_rc(int b, int& R, int& C) { const int st = b / 1024, sb = b % 1024, swz = sb ^ (((sb >> 9) & 1) << 5); R = (st >> 1) * 16 + swz / 64; C = (st & 1) * 32 + (swz % 64) / 2; }
__host__ __device__ __forceinline__ int perm32(int rho) { const int n = rho >> 4, i = rho & 15; return 8 * (i >> 2) + 4 * n + (i & 3); }

struct Unit { int pm, pn; };
struct Gemm { const bf16_t* A; const bf16_t* Bt; int M, N, K; };

struct StaticOrder {
    int nM, nN, nwg, G, c;
    __host__ __device__ void init(int M, int N, int G_, int c_) { nM = M / BM; nN = N / BM; nwg = nM * nN; G = G_; c = c_; }
    __host__ __device__ bool next(int i, Unit& u) const {
        const long L = (long)i * G + c; if (L >= nwg) return false;
        int wgid = (int)L; { const int q = nwg / NXCD, r = nwg % NXCD, xcd = wgid % NXCD, off = wgid / NXCD; wgid = (xcd < r ? xcd * (q + 1) : r * (q + 1) + (xcd - r) * q) + off; }
        const int nig = WGM * nN, gid = wgid / nig, fm = gid * WGM, gsz = (nM - fm) < WGM ? (nM - fm) : WGM;
        u.pm = fm + ((wgid % nig) % gsz); u.pn = (wgid % nig) / gsz; return true;
    }
    __device__ __forceinline__ void a_ready(const Unit&) const {}
    __device__ __forceinline__ void done(const Unit&) const {}
};
__device__ __forceinline__ unsigned cvt_pk_bf16(float lo, float hi) { unsigned r; asm volatile("v_cvt_pk_bf16_f32 %0, %1, %2" : "=v"(r) : "v"(lo), "v"(hi)); return r; }
typedef float f32x2 __attribute__((ext_vector_type(2)));

struct EpiStoreBf16 {
    static constexpr bool PERM = true, AFTER_DRAIN = false;
    bf16_t* O; int ldc;
    __device__ __forceinline__ void operator()(const f32x4 (&acc)[2][2][4][2], const Unit& u, int wr, int wc, int fr, int fq) const {
        const int row0 = u.pm * BM + wr * 64 + fr; const int col0 = u.pn * BM + wc * 32 + 8 * fq;
#pragma unroll
        for (int ai = 0; ai < 2; ++ai)
#pragma unroll
            for (int m = 0; m < 4; ++m) { bf16_t* rowp = O + (size_t)(row0 + ai * HALF + m * 16) * ldc + col0;
#pragma unroll
                for (int bj = 0; bj < 2; ++bj) { const f32x4 v0 = acc[ai][bj][m][0], v1 = acc[ai][bj][m][1];
                    u32x4 w; w.x = cvt_pk_bf16(v0[0], v0[1]); w.y = cvt_pk_bf16(v0[2], v0[3]); w.z = cvt_pk_bf16(v1[0], v1[1]); w.w = cvt_pk_bf16(v1[2], v1[3]);
                    *(u32x4*)(rowp + bj * HALF) = w; } }
    }
};
struct EpiResidF32 {
    static constexpr bool PERM = false, AFTER_DRAIN = false;
    float* C; const float* X; int ldc;
    __device__ __forceinline__ void operator()(const f32x4 (&acc)[2][2][4][2], const Unit& u, int wr, int wc, int fr, int fq) const {
        const int row0 = u.pm * BM + wr * 64 + fr, col0 = u.pn * BM + wc * 32 + 4 * fq;
#pragma unroll
        for (int ai = 0; ai < 2; ++ai)
#pragma unroll
            for (int m = 0; m < 4; ++m) { const size_t off = (size_t)(row0 + ai * HALF + m * 16) * ldc + col0;
#pragma unroll
                for (int bj = 0; bj < 2; ++bj)
#pragma unroll
                    for (int n = 0; n < 2; ++n) { const f32x4 xv = *(const f32x4*)(X + off + bj * HALF + n * 16); *(f32x4*)(C + off + bj * HALF + n * 16) = acc[ai][bj][m][n] + xv; } }
    }
};
struct OneUnit {
    int pm, pn;
    __device__ __forceinline__ bool next(int i, Unit& u) const { if (i) return false; u.pm = pm; u.pn = pn; return true; }
    __device__ __forceinline__ void a_ready(const Unit&) const {}
    __device__ __forceinline__ void done(const Unit&) const {}
};
struct EpiFinal {
    static constexpr bool PERM = false, AFTER_DRAIN = true;
    float* C; const float* X; const float* G; float* rowsq; unsigned* cnt;
    __device__ __forceinline__ void fused(f32x4 (&acc)[2][2][4][2], const Unit& u, int wr, int wc, int fr, int fq, PG8_LAS unsigned char* lds, int wid, int lane) const {
        PG8_LAS float* P = (PG8_LAS float*)lds;
        PG8_LAS float* S = (PG8_LAS float*)(lds + 4096);
        const int tid = wid * 64 + lane;
        const int row0 = u.pm * BM + wr * 64 + fr, col0 = u.pn * BM + wc * 32 + 4 * fq;
#pragma unroll
        for (int ai = 0; ai < 2; ++ai)
#pragma unroll
            for (int m = 0; m < 4; ++m) { const size_t off = (size_t)(row0 + ai * HALF + m * 16) * 1024 + col0; float s = 0.f;
#pragma unroll
                for (int bj = 0; bj < 2; ++bj)
#pragma unroll
                    for (int n = 0; n < 2; ++n) { const f32x4 xv = *(const f32x4*)(X + off + bj * HALF + n * 16); const f32x4 v = acc[ai][bj][m][n] + xv; acc[ai][bj][m][n] = v;
                        s += (v[0] * v[0] + v[1] * v[1]) + (v[2] * v[2] + v[3] * v[3]); }
                s += __shfl_xor(s, 16); s += __shfl_xor(s, 32);
                if (fq == 0) P[(ai * HALF + wr * 64 + m * 16 + fr) * 4 + wc] = s; }
        __syncthreads();
        { float back = 0.f;
          if (tid < 256) { const float tot = (P[tid * 4] + P[tid * 4 + 1]) + (P[tid * 4 + 2] + P[tid * 4 + 3]);
              back = __hip_atomic_fetch_add(rowsq + u.pm * BM + tid, tot, __ATOMIC_RELAXED, __HIP_MEMORY_SCOPE_AGENT); }
          asm volatile("s_waitcnt vmcnt(0)" :: "v"(back) : "memory"); }
        __syncthreads();
        if (tid == 0) {
            __hip_atomic_fetch_add(cnt + u.pm, 1u, __ATOMIC_RELAXED, __HIP_MEMORY_SCOPE_AGENT);
            unsigned sp = 0;
            while (__hip_atomic_load(cnt + u.pm, __ATOMIC_RELAXED, __HIP_MEMORY_SCOPE_AGENT) < 4u) { __builtin_amdgcn_s_sleep(1); if (++sp > (1u << 22)) break; }
        }
        __syncthreads();
        if (tid < 256) S[tid] = __builtin_amdgcn_rsqf(__hip_atomic_load(rowsq + u.pm * BM + tid, __ATOMIC_RELAXED, __HIP_MEMORY_SCOPE_AGENT) * (1.0f / 1024.0f) + 1e-6f);
        __syncthreads();
        f32x4 gv[2][2];
#pragma unroll
        for (int bj = 0; bj < 2; ++bj)
#pragma unroll
            for (int n = 0; n < 2; ++n) gv[bj][n] = *(const f32x4*)(G + col0 + bj * HALF + n * 16);
#pragma unroll
        for (int ai = 0; ai < 2; ++ai)
#pragma unroll
            for (int m = 0; m < 4; ++m) { const size_t off = (size_t)(row0 + ai * HALF + m * 16) * 1024 + col0; const float rs = S[ai * HALF + wr * 64 + m * 16 + fr];
#pragma unroll
                for (int bj = 0; bj < 2; ++bj)
#pragma unroll
                    for (int n = 0; n < 2; ++n) *(f32x4*)(C + off + bj * HALF + n * 16) = acc[ai][bj][m][n] * rs * gv[bj][n]; }
        __syncthreads();
    }
};
template <class Epi, class Sched, bool STAMP = false>
__device__ __forceinline__ void gemm_phase(PG8_LAS unsigned char* lds, const Gemm g, const Sched& S, const Epi& E, unsigned long long* stamps) {
    const int tid = threadIdx.x, wid = __builtin_amdgcn_readfirstlane(tid >> 6), lane = tid & 63, wr = wid >> 2, wc = wid & 3, fr = lane & 15, fq = lane >> 4;
    const int K = g.K, nt = K / BK;
    int ts_lo = 0, ts_hi = 0, nts = 0; const unsigned long long rt_entry = STAMP ? (unsigned long long)wall_clock64() : 0ull;
#define PG8_STAMP() do { if (STAMP && wid == 0 && nts < 64) { const unsigned long long _c = (unsigned long long)clock64(); \
        ts_lo = (lane == nts) ? (int)(unsigned)_c : ts_lo; ts_hi = (lane == nts) ? (int)(unsigned)(_c >> 32) : ts_hi; ++nts; } } while (0)
    PG8_STAMP();
    unsigned voffA[2], voffB[2];
#pragma unroll
    for (int i = 0; i < 2; ++i) { int R, C; stage_rc(tid * 16 + i * 8192, R, C); const int Rb = Epi::PERM ? ((R & ~31) + perm32(R & 31)) : R;
        voffA[i] = (unsigned)(R * K + C) * 2u; voffB[i] = (unsigned)(Rb * K + C) * 2u; }
    const size_t kstep = (size_t)(BK * 2);
    const size_t hstep = (size_t)HALF * K * 2;
    const size_t tstep = 2 * hstep;
    const unsigned ldsw = (unsigned)wid * 1024u;
    const int aoff = lds_byte(wr * 64 + fr, fq * 8), boff = lds_byte(wc * 32 + fr, fq * 8);
#define PG8_SA(b, h) (((b) * 2 + (h)) * HTB)
#define PG8_SB(b, h) ((4 + (b) * 2 + (h)) * HTB)
#define PG8_STAGE(bufoff, gbase, voff) do { _Pragma("unroll") for (int _i = 0; _i < 2; ++_i) \
        __builtin_amdgcn_global_load_lds((const unsigned*)((const char*)(gbase) + (voff)[_i]), (PG8_LAS unsigned*)(lds + (bufoff) + ldsw + _i * 8192), 16, 0, 0); } while (0)
#define PG8_LDA(dst, b, h) do { _Pragma("unroll") for (int m = 0; m < 4; ++m) _Pragma("unroll") for (int k = 0; k < 2; ++k) dst[m][k] = *(const PG8_LAS bf16x8*)(lds + PG8_SA(b, h) + aoff + m * 2048 + k * 1024); } while (0)
#define PG8_LDB(dst, b, h) do { _Pragma("unroll") for (int n = 0; n < 2; ++n) _Pragma("unroll") for (int k = 0; k < 2; ++k) dst[n][k] = *(const PG8_LAS bf16x8*)(lds + PG8_SB(b, h) + boff + n * 2048 + k * 1024); } while (0)
#define PG8_MMA(ai, bj, At, Bt) do { __builtin_amdgcn_s_setprio(1); _Pragma("unroll") for (int m = 0; m < 4; ++m) _Pragma("unroll") for (int n = 0; n < 2; ++n) _Pragma("unroll") for (int k = 0; k < 2; ++k) \
        acc[ai][bj][m][n] = __builtin_amdgcn_mfma_f32_16x16x32_bf16(Bt[n][k], At[m][k], acc[ai][bj][m][n], 0, 0, 0); __builtin_amdgcn_s_setprio(0); } while (0)
#define PG8_WAIT_V(n) asm volatile("s_waitcnt vmcnt(" #n ")" ::: "memory")
#define PG8_WAIT_L(n) asm volatile("s_waitcnt lgkmcnt(" #n ")" ::: "memory")
#define PG8_BAR __builtin_amdgcn_s_barrier()
#define PG8_SCHED __builtin_amdgcn_sched_barrier(0)
    Unit cur, nxt; int ui = 0;
    if (!S.next(0, cur)) return;
    f32x4 acc[2][2][4][2];
#pragma unroll
    for (int a = 0; a < 2; ++a)
#pragma unroll
        for (int b = 0; b < 2; ++b)
#pragma unroll
            for (int m = 0; m < 4; ++m)
#pragma unroll
                for (int n = 0; n < 2; ++n) acc[a][b][m][n] = (f32x4){0.f, 0.f, 0.f, 0.f};
    bf16x8 At[4][2], B0[2][2], B1[2][2];
    const char* cA = (const char*)g.A + (size_t)cur.pm * tstep; const char* cB = (const char*)g.Bt + (size_t)cur.pn * tstep;
    S.a_ready(cur);
    PG8_STAGE(PG8_SB(0, 0), cB, voffB); PG8_STAGE(PG8_SA(0, 0), cA, voffA); PG8_STAGE(PG8_SB(0, 1), cB + hstep, voffB); PG8_STAGE(PG8_SA(0, 1), cA + hstep, voffA);
    if (wr == 1) PG8_BAR;
    PG8_WAIT_V(4); PG8_BAR;
    PG8_STAGE(PG8_SB(1, 0), cB + kstep, voffB); PG8_STAGE(PG8_SA(1, 0), cA + kstep, voffA); PG8_STAGE(PG8_SB(1, 1), cB + hstep + kstep, voffB);
    PG8_WAIT_V(6); PG8_BAR;
    PG8_STAMP();
    for (;;) {
        const bool has_next = S.next(ui + 1, nxt);
        const char* nA = has_next ? (const char*)g.A + (size_t)nxt.pm * tstep : cA; const char* nB = has_next ? (const char*)g.Bt + (size_t)nxt.pn * tstep : cB;
        for (int t = 0; t < nt; t += 2) {
            const bool last = (t == nt - 2);
            const char* a1 = cA + (size_t)(t + 1) * kstep;
            const char* a2 = last ? nA : cA + (size_t)(t + 2) * kstep; const char* b2 = last ? nB : cB + (size_t)(t + 2) * kstep;
            const char* a3 = a2 + kstep; const char* b3 = b2 + kstep;
            if (last && has_next) S.a_ready(nxt);
            PG8_LDB(B0, 0, 0); PG8_SCHED; PG8_LDA(At, 0, 0); PG8_STAGE(PG8_SA(1, 1), a1 + hstep, voffA);
            PG8_WAIT_L(8); PG8_BAR; PG8_WAIT_L(0); PG8_MMA(0, 0, At, B0); PG8_BAR; PG8_SCHED;
            PG8_LDB(B1, 0, 1); PG8_STAGE(PG8_SB(0, 0), b2, voffB);
            PG8_BAR; PG8_WAIT_L(0); PG8_MMA(0, 1, At, B1); PG8_BAR;
            PG8_LDA(At, 0, 1); PG8_STAGE(PG8_SA(0, 0), a2, voffA);
            PG8_BAR; PG8_WAIT_L(0); PG8_MMA(1, 0, At, B0); PG8_BAR; PG8_SCHED;
            PG8_STAGE(PG8_SB(0, 1), b2 + hstep, voffB);
            PG8_WAIT_V(6); PG8_BAR; PG8_MMA(1, 1, At, B1); PG8_BAR;
            PG8_LDB(B0, 1, 0); PG8_SCHED; PG8_LDA(At, 1, 0); PG8_STAGE(PG8_SA(0, 1), a2 + hstep, voffA);
            PG8_WAIT_L(8); PG8_BAR; PG8_WAIT_L(0); PG8_MMA(0, 0, At, B0); PG8_BAR; PG8_SCHED;
            PG8_LDB(B1, 1, 1); PG8_STAGE(PG8_SB(1, 0), b3, voffB);
            PG8_BAR; PG8_WAIT_L(0); PG8_MMA(0, 1, At, B1); PG8_BAR;
            PG8_LDA(At, 1, 1); PG8_STAGE(PG8_SA(1, 0), a3, voffA);
            PG8_BAR; PG8_WAIT_L(0); PG8_MMA(1, 0, At, B0); PG8_BAR; PG8_SCHED;
            PG8_STAGE(PG8_SB(1, 1), b3 + hstep, voffB);
            PG8_WAIT_V(6); PG8_BAR; PG8_MMA(1, 1, At, B1); PG8_BAR;
        }
        PG8_STAMP();
        if constexpr (!Epi::AFTER_DRAIN) { E(acc, cur, wr, wc, fr, fq); S.done(cur); }
        PG8_STAMP();
        if (!has_next) break;
#pragma unroll
        for (int a = 0; a < 2; ++a)
#pragma unroll
            for (int b = 0; b < 2; ++b)
#pragma unroll
                for (int m = 0; m < 4; ++m)
#pragma unroll
                    for (int n = 0; n < 2; ++n) acc[a][b][m][n] = (f32x4){0.f, 0.f, 0.f, 0.f};
        cur = nxt; cA = nA; cB = nB; ++ui;
    }
    PG8_WAIT_V(0);
    if (wr == 0) PG8_BAR;
    PG8_BAR;
    if constexpr (Epi::AFTER_DRAIN) { E.fused(acc, cur, wr, wc, fr, fq, lds, wid, lane); S.done(cur); }
    PG8_STAMP();
    if (STAMP && wid == 0) { stamps[lane] = lane < nts ? (((unsigned long long)(unsigned)ts_hi << 32) | (unsigned)ts_lo) : 0ull;
        if (lane == 62) stamps[62] = rt_entry; if (lane == 63) stamps[63] = (unsigned long long)wall_clock64(); }
#undef PG8_STAMP
#undef PG8_SA
#undef PG8_SB
#undef PG8_STAGE
#undef PG8_LDA
#undef PG8_LDB
#undef PG8_MMA
#undef PG8_WAIT_V
#undef PG8_WAIT_L
#undef PG8_BAR
#undef PG8_SCHED
}
}

using pg8::bf16_t;
typedef short bf16x8_t __attribute__((ext_vector_type(8)));
typedef float f32x4_t __attribute__((ext_vector_type(4)));

constexpr int NB = 8, SEQ = 8192, DM = 1024, DH = 768, NTOK = NB * SEQ;
constexpr size_t MiB = 1ull << 20;
constexpr size_t OFF_XN = 0, OFF_YHT = 0, OFF_HYT = 128 * MiB, OFF_YCAT = 128 * MiB, OFF_P2 = 416 * MiB, OFF_KF = 704 * MiB, OFF_KH = 752 * MiB,
                 OFF_HF = 784 * MiB, OFF_HB = 880 * MiB, OFF_WT1 = 976 * MiB, OFF_WT2 = 985 * MiB, OFF_PS = 988 * MiB, OFF_CTL = 990 * MiB, OFF_XBAR = OFF_CTL + 16384, OFF_CNT = OFF_CTL + 4096, OFF_ROWSQ = OFF_CTL + 65536, WS_END = 991 * MiB;
constexpr int NFFT = 16384;
constexpr int ZPHYS = NFFT + (NFFT / 64) * 4;
constexpr int LDS_BYTES = ZPHYS * 8 + 256;
constexpr int N_LRU_UNITS = 192, N_HY_UNITS = 768, N_HY_FULL = 640;
#ifndef MIX_SEL
#define MIX_SEL 0
#endif

struct Params { const float* in[27]; float* out; unsigned char* ws; int ph_lo, ph_hi; };

__device__ __forceinline__ float bf2f(unsigned short b) { return __uint_as_float(((unsigned)b) << 16); }
__device__ __forceinline__ float bflo(unsigned w) { return __uint_as_float(w << 16); }
__device__ __forceinline__ float bfhi(unsigned w) { return __uint_as_float(w & 0xffff0000u); }
__device__ __forceinline__ unsigned pk(float a, float b) { return pg8::cvt_pk_bf16(a, b); }
__device__ __forceinline__ float wave_sum(float v) {
#pragma unroll
    for (int o = 32; o; o >>= 1) v += __shfl_xor(v, o);
    return v; }
__device__ __forceinline__ float sigm(float x) { return __builtin_amdgcn_rcpf(1.0f + __expf(-x)); }
__device__ __forceinline__ float sin_rad(float x) { const float r = x * 0.15915494309189535f; return __builtin_amdgcn_sinf(r - floorf(r)); }
__device__ __forceinline__ float cos_rad(float x) { const float r = x * 0.15915494309189535f; return __builtin_amdgcn_cosf(r - floorf(r)); }

__device__ void phase_xn(const Params& p) {
    const int tid = threadIdx.x, lane = tid & 63, wid = tid >> 6;
    const float* x = p.in[0]; bf16_t* XN = (bf16_t*)(p.ws + OFF_XN);
    for (int row = (blockIdx.x * 8 + wid) * 4; row < NTOK; row += gridDim.x * 32) {
        float4 v[4][4]; float ss[4];
#pragma unroll
        for (int r = 0; r < 4; ++r) { const float4* src = (const float4*)(x + (size_t)(row + r) * DM);
#pragma unroll
            for (int i = 0; i < 4; ++i) v[r][i] = src[i * 64 + lane]; }
#pragma unroll
        for (int r = 0; r < 4; ++r) { float s = 0.f;
#pragma unroll
            for (int i = 0; i < 4; ++i) s += v[r][i].x * v[r][i].x + v[r][i].y * v[r][i].y + v[r][i].z * v[r][i].z + v[r][i].w * v[r][i].w;
            ss[r] = wave_sum(s); }
#pragma unroll
        for (int r = 0; r < 4; ++r) { const float rs = rsqrtf(ss[r] * (1.0f / DM) + 1e-6f); uint2* dst = (uint2*)(XN + (size_t)(row + r) * DM);
#pragma unroll
            for (int i = 0; i < 4; ++i) { uint2 w; w.x = pk(v[r][i].x * rs, v[r][i].y * rs); w.y = pk(v[r][i].z * rs, v[r][i].w * rs); dst[i * 64 + lane] = w; } }
    }
}
__device__ void transpose_to_bf16(const float* src, int R, int C, const float* rowscale, bf16_t* dst, float* tile) {
    const int tid = threadIdx.x; const int tc = C / 64, nt = (R / 64) * tc;
    for (int t = blockIdx.x; t < nt; t += gridDim.x) {
        const int r0 = (t / tc) * 64, c0 = (t % tc) * 64;
        __syncthreads();
#pragma unroll
        for (int i = 0; i < 2; ++i) { const int r = (tid >> 4) + 32 * i, c4 = (tid & 15) * 4;
            const float4 v = *(const float4*)(src + (size_t)(r0 + r) * C + c0 + c4); const float s = rowscale ? rowscale[r0 + r] : 1.0f;
            tile[r * 65 + c4 + 0] = v.x * s; tile[r * 65 + c4 + 1] = v.y * s; tile[r * 65 + c4 + 2] = v.z * s; tile[r * 65 + c4 + 3] = v.w * s; }
        __syncthreads();
        { const int c = tid >> 3, r8 = (tid & 7) * 8; float v[8];
#pragma unroll
          for (int e = 0; e < 8; ++e) v[e] = tile[(r8 + e) * 65 + c];
          uint4 w; w.x = pk(v[0], v[1]); w.y = pk(v[2], v[3]); w.z = pk(v[4], v[5]); w.w = pk(v[6], v[7]);
          *(uint4*)(dst + (size_t)(c0 + c) * R + r0 + r8) = w; }
    }
}
__device__ void phase_filter(const Params& p, unsigned char* lds) {
    const int tid = threadIdx.x;
    float* Z = (float*)lds; float* H1 = Z + 32 * 33; float* H2 = H1 + 2048; float* H3 = H2 + 2048;
    const float *w1 = p.in[5], *b1 = p.in[6], *f1 = p.in[7], *w2 = p.in[8], *b2 = p.in[9], *f2 = p.in[10], *w3 = p.in[11], *b3 = p.in[12], *f3 = p.in[13], *w4 = p.in[14];
    float* KF = (float*)(p.ws + OFF_KF); float* PS = (float*)(p.ws + OFF_PS);
    const float MIN_DECAY = -15.350567286626973f, MAX_DECAY = -3.0701134573253945f;
    for (int item = blockIdx.x; item < 256; item += gridDim.x) {
        const int j0 = item * 32;
        __syncthreads();
        for (int idx = tid; idx < 32 * 33; idx += 512) { const int row = idx / 33, i = idx % 33, j = j0 + row; float val;
            if (i == 0) val = (float)j * (1.0f / 8191.0f);
            else { const int m = (i - 1) & 15; const float fm = 1e-4f + (float)m * ((15.0f - 1e-4f) / 15.0f); const float wj = (float)j * (6.283185307179586f / 8192.0f); const float xx = wj * fm;
                val = (i <= 16) ? cos_rad(xx) : -sin_rad(xx); }
            Z[idx] = val; }
        __syncthreads();
        { int o = tid & 63; asm volatile("" : "+v"(o)); const int w8 = tid >> 6;
          { float wr[33];
#pragma unroll
            for (int i = 0; i < 33; ++i) wr[i] = w1[i * 64 + o];
            const float bo = b1[o], fo = f1[o];
#pragma unroll 1
            for (int k = 0; k < 4; ++k) { const int row = w8 + 8 * k; float acc = bo;
#pragma unroll
                for (int i = 0; i < 33; ++i) acc += Z[row * 33 + i] * wr[i];
                H1[row * 64 + o] = sin_rad(fo * acc); } }
          __syncthreads();
          { float wr[64];
#pragma unroll
            for (int i = 0; i < 64; ++i) wr[i] = w2[i * 64 + o];
            const float bo = b2[o], fo = f2[o];
#pragma unroll 1
            for (int k = 0; k < 4; ++k) { const int row = w8 + 8 * k; float acc = bo; const float4* h4 = (const float4*)(H1 + row * 64);
#pragma unroll
                for (int i4 = 0; i4 < 16; ++i4) { const float4 hv = h4[i4]; acc += hv.x * wr[4 * i4] + hv.y * wr[4 * i4 + 1] + hv.z * wr[4 * i4 + 2] + hv.w * wr[4 * i4 + 3]; }
                H2[row * 64 + o] = sin_rad(fo * acc); } }
          __syncthreads();
          { float wr[64];
#pragma unroll
            for (int i = 0; i < 64; ++i) wr[i] = w3[i * 64 + o];
            const float bo = b3[o], fo = f3[o];
#pragma unroll 1
            for (int k = 0; k < 4; ++k) { const int row = w8 + 8 * k; float acc = bo; const float4* h4 = (const float4*)(H2 + row * 64);
#pragma unroll
                for (int i4 = 0; i4 < 16; ++i4) { const float4 hv = h4[i4]; acc += hv.x * wr[4 * i4] + hv.y * wr[4 * i4 + 1] + hv.z * wr[4 * i4 + 2] + hv.w * wr[4 * i4 + 3]; }
                ((unsigned short*)H3)[row * 72 + o] = (unsigned short)(pk(sin_rad(fo * acc), 0.f) & 0xffffu); } }
          __syncthreads(); }
        { const int lane = tid & 63, wv = tid >> 6, g4 = lane >> 4, l16 = lane & 15; const bf16_t* H3B = (const bf16_t*)H3;
          bf16x8_t afr[2][2];
#pragma unroll
          for (int rt = 0; rt < 2; ++rt)
#pragma unroll
              for (int ks = 0; ks < 2; ++ks) afr[rt][ks] = *(const bf16x8_t*)(H3B + (16 * rt + l16) * 72 + 32 * ks + 8 * g4);
#pragma unroll 2
          for (int ctl = 0; ctl < 12; ++ctl) {
              const int cp = 16 * (wv * 12 + ctl) + l16;
              float wf[2][8];
#pragma unroll
              for (int ks = 0; ks < 2; ++ks)
#pragma unroll
                  for (int e = 0; e < 8; ++e) wf[ks][e] = w4[(32 * ks + 8 * g4 + e) * 1536 + cp];
              f32x4_t acc[2] = {{0.f, 0.f, 0.f, 0.f}, {0.f, 0.f, 0.f, 0.f}};
#pragma unroll
              for (int ks = 0; ks < 2; ++ks) { uint4 bw; bw.x = pk(wf[ks][0], wf[ks][1]); bw.y = pk(wf[ks][2], wf[ks][3]); bw.z = pk(wf[ks][4], wf[ks][5]); bw.w = pk(wf[ks][6], wf[ks][7]);
#pragma unroll
                  for (int rt = 0; rt < 2; ++rt) acc[rt] = __builtin_amdgcn_mfma_f32_16x16x32_bf16(afr[rt][ks], __builtin_bit_cast(bf16x8_t, bw), acc[rt], 0, 0, 0); }
              const bool bwd = cp >= DH; const int c = bwd ? cp - DH : cp;
              const float ad = fabsf(MIN_DECAY + (float)c * ((MAX_DECAY - MIN_DECAY) / 767.0f));
              float asum = 0.f; float* kc = KF + (size_t)c * NFFT + (bwd ? SEQ : 0);
#pragma unroll
              for (int rt = 0; rt < 2; ++rt) { float v[4];
#pragma unroll
                  for (int jj = 0; jj < 4; ++jj) { const int j = j0 + 16 * rt + 4 * g4 + jj; const float tj = (float)j * (1.0f / 8191.0f); v[jj] = acc[rt][jj] * __expf(-tj * ad); if (!bwd || j >= 1) asum += fabsf(v[jj]); }
                  *(float4*)(kc + j0 + 16 * rt + 4 * g4) = make_float4(v[0], v[1], v[2], v[3]); }
              asum += __shfl_xor(asum, 16); asum += __shfl_xor(asum, 32);
              if (g4 == 0) PS[item * 1536 + cp] = asum;
          } }
    }
}
__device__ void phase0(const Params& p, unsigned char* lds) {
    { float* rq = (float*)(p.ws + OFF_ROWSQ); for (int i = blockIdx.x * 512 + threadIdx.x; i < NTOK; i += gridDim.x * 512) rq[i] = 0.f; }
    const bool filter_first = (blockIdx.x & 1) != 0;
    if (filter_first) { phase_filter(p, lds); __syncthreads(); }
    phase_xn(p);
    transpose_to_bf16(p.in[2], DM, 4608, p.in[1], (bf16_t*)(p.ws + OFF_WT1), (float*)lds);
    transpose_to_bf16(p.in[25], 1536, DM, nullptr, (bf16_t*)(p.ws + OFF_WT2), (float*)lds);
    if (!filter_first) phase_filter(p, lds);
}
__device__ void phase_gemm1(const Params& p, unsigned char* lds) {
    PG8_LAS unsigned char* l3 = (PG8_LAS unsigned char*)lds;
    const bf16_t* XN = (const bf16_t*)(p.ws + OFF_XN); const bf16_t* WT1 = (const bf16_t*)(p.ws + OFF_WT1);
#pragma unroll 1
    for (int pass = 0; pass < 2; ++pass) {
        int ps = pass; asm volatile("" : "+s"(ps));
        pg8::StaticOrder S; pg8::Gemm g; pg8::EpiStoreBf16 E;
        g.A = ps ? XN : WT1; g.Bt = ps ? WT1 + (size_t)2304 * DM : XN; g.M = ps ? NTOK : 2304; g.N = ps ? 2304 : NTOK; g.K = DM;
        E.O = (bf16_t*)(p.ws + (ps ? OFF_P2 : OFF_HYT)); E.ldc = g.N;
        S.init(g.M, g.N, (int)gridDim.x, (int)blockIdx.x);
        pg8::gemm_phase<pg8::EpiStoreBf16, pg8::StaticOrder, false>(l3, g, S, E, nullptr);
        __syncthreads();
    }
}
__device__ void phase_gemm2(const Params& p, unsigned char* lds) {
    PG8_LAS unsigned char* l3 = (PG8_LAS unsigned char*)lds;
    pg8::Gemm g{(const bf16_t*)(p.ws + OFF_YCAT), (const bf16_t*)(p.ws + OFF_WT2), NTOK, DM, 1536};
    pg8::EpiFinal E{p.out, p.in[0], p.in[26], (float*)(p.ws + OFF_ROWSQ), (unsigned*)(p.ws + OFF_CNT)};
    const int G = (int)gridDim.x;
#pragma unroll 1
    for (int L = (int)blockIdx.x; L < 1024; L += G) {
        pg8::OneUnit S;
        if (G == 256) { const int r = L >> 8, c = L & 255, x = c & 7, t = c >> 3; S.pm = 64 * r + x * 8 + (t >> 2); S.pn = t & 3; }
        else { S.pm = L >> 2; S.pn = L & 3; }
        pg8::gemm_phase<pg8::EpiFinal, pg8::OneUnit, false>(l3, g, S, E, nullptr);
        __syncthreads();
    }
}
typedef float v2 __attribute__((ext_vector_type(2)));
__device__ __forceinline__ int phys(int e) { return e + ((e >> 5) << 1); }
__device__ __forceinline__ v2 cmulv(v2 a, v2 b) { v2 t, r;
    asm("v_pk_mul_f32 %0, %1, %2 op_sel:[0,0] op_sel_hi:[0,1]" : "=v"(t) : "v"(a), "v"(b));
    asm("v_pk_fma_f32 %0, %1, %2, %3 op_sel:[1,1,0] op_sel_hi:[1,0,1] neg_lo:[0,1,0]" : "=v"(r) : "v"(a), "v"(b), "v"(t));
    return r; }
template <int SGN> __device__ __forceinline__ void addsub_rot(v2 a, v2 b, v2& p, v2& m) {
    if (SGN < 0) { asm("v_pk_add_f32 %0, %1, %2 op_sel:[0,1] op_sel_hi:[1,0] neg_hi:[0,1]" : "=v"(p) : "v"(a), "v"(b));
                   asm("v_pk_add_f32 %0, %1, %2 op_sel:[0,1] op_sel_hi:[1,0] neg_lo:[0,1]" : "=v"(m) : "v"(a), "v"(b)); }
    else         { asm("v_pk_add_f32 %0, %1, %2 op_sel:[0,1] op_sel_hi:[1,0] neg_lo:[0,1]" : "=v"(p) : "v"(a), "v"(b));
                   asm("v_pk_add_f32 %0, %1, %2 op_sel:[0,1] op_sel_hi:[1,0] neg_hi:[0,1]" : "=v"(m) : "v"(a), "v"(b)); }
}
__device__ __forceinline__ constexpr float c16(int k) { return k == 0 ? 1.0f : k == 1 ? 0.9238795325112867f : k == 2 ? 0.7071067811865476f : k == 3 ? 0.3826834323650898f : k == 4 ? 0.0f : k == 6 ? -0.7071067811865476f : k == 9 ? -0.9238795325112867f : 0.0f; }
__device__ __forceinline__ constexpr float s16(int k) { return k == 0 ? 0.0f : k == 1 ? 0.3826834323650898f : k == 2 ? 0.7071067811865476f : k == 3 ? 0.9238795325112867f : k == 4 ? 1.0f : k == 6 ? 0.7071067811865476f : k == 9 ? -0.3826834323650898f : 0.0f; }
template <int SGN> __device__ __forceinline__ void bfly4(v2& a0, v2& a1, v2& a2, v2& a3) {
    const v2 t0 = a0 + a2, t1 = a0 - a2, t2 = a1 + a3, t3 = a1 - a3;
    a0 = t0 + t2; a2 = t0 - t2; addsub_rot<SGN>(t1, t3, a1, a3);
}
template <int SGN> __device__ __forceinline__ void dft16(v2 (&x)[16]) {
#pragma unroll
    for (int q2 = 0; q2 < 4; ++q2) bfly4<SGN>(x[q2], x[q2 + 4], x[q2 + 8], x[q2 + 12]);
#pragma unroll
    for (int q2 = 1; q2 < 4; ++q2)
#pragma unroll
        for (int r1 = 1; r1 < 4; ++r1) { const int k = q2 * r1; const v2 w = {c16(k), (float)SGN * s16(k)}; x[q2 + 4 * r1] = cmulv(x[q2 + 4 * r1], w); }
#pragma unroll
    for (int r1 = 0; r1 < 4; ++r1) bfly4<SGN>(x[4 * r1], x[4 * r1 + 1], x[4 * r1 + 2], x[4 * r1 + 3]);
}
#define FFT_TW_CHAIN() v2 tw[16]; { const float ang = (float)j * (1.0f / (float)M); const float sn = __builtin_amdgcn_sinf(ang), cs = __builtin_amdgcn_cosf(ang); \
          tw[0] = (v2){1.f, 0.f}; tw[1] = (v2){cs, (float)SGN * sn}; tw[2] = cmulv(tw[1], tw[1]); tw[3] = cmulv(tw[2], tw[1]); tw[4] = cmulv(tw[2], tw[2]); tw[5] = cmulv(tw[4], tw[1]); tw[6] = cmulv(tw[3], tw[3]); tw[7] = cmulv(tw[4], tw[3]); \
          tw[8] = cmulv(tw[4], tw[4]); tw[9] = cmulv(tw[8], tw[1]); tw[10] = cmulv(tw[5], tw[5]); tw[11] = cmulv(tw[8], tw[3]); tw[12] = cmulv(tw[6], tw[6]); tw[13] = cmulv(tw[8], tw[5]); tw[14] = cmulv(tw[7], tw[7]); tw[15] = cmulv(tw[8], tw[7]); }
template <int M, int SGN, int HALF> __device__ __forceinline__ void fft_pass16(v2* z, int tid) {
    constexpr int S = M / 16; constexpr int PS = (S >= 64) ? S + S / 16 : S;
#pragma unroll 1
    for (int it = 0; it < 2; ++it) {
        int t = tid + it * 512; asm volatile("" : "+v"(t)); const int j = t & (S - 1); const int base = (t / S) * M;
        v2* zp = z + phys(base + j);
        v2 x[16];
#pragma unroll
        for (int q = 0; q < 16; ++q) x[q] = (HALF && SGN < 0 && q >= 8) ? (v2){0.f, 0.f} : zp[q * PS];
        const float ang = (float)j * (1.0f / (float)M); const v2 w1 = {__builtin_amdgcn_cosf(ang), (float)SGN * __builtin_amdgcn_sinf(ang)};
        if (SGN > 0) { v2 w = w1;
#pragma unroll
            for (int q = 1; q < 16; ++q) { x[q] = cmulv(x[q], w); if (q < 15) w = cmulv(w, w1); }
            dft16<SGN>(x);
#pragma unroll
            for (int pp = 0; pp < 16; ++pp) { const int r = (pp >> 2) + 4 * (pp & 3); if (HALF && r >= 8) continue; zp[r * PS] = x[pp]; }
        } else {
            dft16<SGN>(x);
            v2 w = w1; zp[0] = x[0];
#pragma unroll
            for (int r = 1; r < 16; ++r) { const int pp = 4 * (r & 3) + (r >> 2); zp[r * PS] = cmulv(x[pp], w); if (r < 15) w = cmulv(w, w1); }
        }
    }
}
__device__ __forceinline__ constexpr float c32(int k) { return k == 0 ? 1.0f : k == 1 ? 0.9807852804032304f : k == 2 ? 0.9238795325112867f : k == 3 ? 0.8314696123025452f : k == 4 ? 0.7071067811865476f : k == 5 ? 0.5555702330196022f : k == 6 ? 0.3826834323650898f : k == 7 ? 0.1950903220161283f : k == 8 ? 0.0f
    : k == 9 ? -0.1950903220161283f : k == 10 ? -0.3826834323650898f : k == 11 ? -0.5555702330196022f : k == 12 ? -0.7071067811865476f : k == 13 ? -0.8314696123025452f : k == 14 ? -0.9238795325112867f : -0.9807852804032304f; }
__device__ __forceinline__ constexpr float s32(int k) { return k == 0 ? 0.0f : k == 1 ? 0.1950903220161283f : k == 2 ? 0.3826834323650898f : k == 3 ? 0.5555702330196022f : k == 4 ? 0.7071067811865476f : k == 5 ? 0.8314696123025452f : k == 6 ? 0.9238795325112867f : k == 7 ? 0.9807852804032304f : k == 8 ? 1.0f
    : k == 9 ? 0.9807852804032304f : k == 10 ? 0.9238795325112867f : k == 11 ? 0.8314696123025452f : k == 12 ? 0.7071067811865476f : k == 13 ? 0.5555702330196022f : k == 14 ? 0.3826834323650898f : 0.1950903220161283f; }
template <int SGN> __device__ __forceinline__ void dft32(v2 (&x)[32]) {
    v2 E[16], O[16];
#pragma unroll
    for (int i = 0; i < 16; ++i) { E[i] = x[2 * i]; O[i] = x[2 * i + 1]; }
    dft16<SGN>(E); dft16<SGN>(O);
#pragma unroll
    for (int k = 0; k < 16; ++k) { const int pp = 4 * (k & 3) + (k >> 2); v2 o = O[pp];
        if (k > 0) { const v2 w = {c32(k), (float)SGN * s32(k)}; o = cmulv(o, w); }
        x[k] = E[pp] + o; x[k + 16] = E[pp] - o; }
}
template <int SGN> __device__ __forceinline__ void fft_pass32(v2* z, int tid) {
    int t = tid; asm volatile("" : "+v"(t)); const int j = t & 31; v2* zp = z + phys((t >> 5) * 1024 + j);
    v2 x[32];
#pragma unroll
    for (int q = 0; q < 32; ++q) x[q] = zp[34 * q];
    const float ang = (float)j * (1.0f / 1024.0f); const v2 w1 = {__builtin_amdgcn_cosf(ang), (float)SGN * __builtin_amdgcn_sinf(ang)};
    if (SGN > 0) { v2 w = w1;
#pragma unroll
        for (int q = 1; q < 32; ++q) { x[q] = cmulv(x[q], w); if (q < 31) w = cmulv(w, w1); }
        dft32<SGN>(x);
#pragma unroll
        for (int q = 0; q < 32; ++q) zp[34 * q] = x[q];
    } else {
        dft32<SGN>(x);
        v2 w = w1; zp[0] = x[0];
#pragma unroll
        for (int r = 1; r < 32; ++r) { zp[34 * r] = cmulv(x[r], w); if (r < 31) w = cmulv(w, w1); }
    }
}
__device__ __forceinline__ void ld32(const v2* z, int tid, v2 (&x)[32]) { const float4* s = (const float4*)(z + phys(32 * tid));
#pragma unroll
    for (int i = 0; i < 16; ++i) { const float4 a = s[i]; x[2 * i] = (v2){a.x, a.y}; x[2 * i + 1] = (v2){a.z, a.w}; } }
__device__ __forceinline__ void st32(v2* z, int tid, const v2 (&x)[32]) { float4* s = (float4*)(z + phys(32 * tid));
#pragma unroll
    for (int i = 0; i < 16; ++i) s[i] = make_float4(x[2 * i].x, x[2 * i].y, x[2 * i + 1].x, x[2 * i + 1].y); }
struct In6 { uint2 w; unsigned halo; };
__device__ __forceinline__ In6 ld6(const bf16_t* seq, int l4) { In6 r; r.w = *(const uint2*)(seq + l4); const unsigned lo = l4 > 0 ? seq[l4 - 1] : 0u, hi = (l4 + 4 < SEQ) ? seq[l4 + 4] : 0u; r.halo = lo | (hi << 16); return r; }
__device__ __forceinline__ void conv3(const In6& in, float w0, float w1, float w2, float bb, float (&o)[4]) {
    const float i0 = bflo(in.halo), i1 = bflo(in.w.x), i2 = bfhi(in.w.x), i3 = bflo(in.w.y), i4 = bfhi(in.w.y), i5 = bfhi(in.halo);
    o[0] = bb + w0 * i0 + w1 * i1 + w2 * i2; o[1] = bb + w0 * i1 + w1 * i2 + w2 * i3; o[2] = bb + w0 * i2 + w1 * i3 + w2 * i4; o[3] = bb + w0 * i3 + w1 * i4 + w2 * i5;
}
__device__ void hyena_unit(const Params& p, unsigned char* lds, int c, int pr_lo, int pr_hi) {
    int tid = threadIdx.x; asm volatile("" : "+v"(tid)); const int lane = tid & 63, wid = tid >> 6;
    v2* z = (v2*)lds; float* red = (float*)(lds + ZPHYS * 8);
    const bf16_t* HYT = (const bf16_t*)(p.ws + OFF_HYT); bf16_t* YHT = (bf16_t*)(p.ws + OFF_YHT);
    const float* PS = (const float*)(p.ws + OFF_PS); const float* kf = (const float*)(p.ws + OFF_KF) + (size_t)c * NFFT;
    __syncthreads();
    { float part = 0.f; if (tid < 256) part = PS[tid * 1536 + c] + PS[tid * 1536 + DH + c];
      part = wave_sum(part); if (lane == 0 && wid < 4) red[wid] = part; }
    { float4 kv[8];
#pragma unroll
      for (int it = 0; it < 8; ++it) { const int e4 = (tid + 512 * it) * 4;
          if (it < 4) kv[it] = *(const float4*)(kf + e4);
          else { const float* q = kf + (3 * SEQ - e4); kv[it] = make_float4(e4 == SEQ ? 0.f : q[0], q[-1], q[-2], q[-3]); } }
      __syncthreads();
      const float scale = 1.0f / ((red[0] + red[1] + red[2] + red[3] + 1e-6f) * (float)NFFT);
#pragma unroll
      for (int it = 0; it < 8; ++it) { const int e4 = (tid + 512 * it) * 4; float4* d = (float4*)(z + phys(e4));
          d[0] = make_float4(kv[it].x * scale, 0.f, kv[it].y * scale, 0.f); d[1] = make_float4(kv[it].z * scale, 0.f, kv[it].w * scale, 0.f); } }
    __syncthreads();
    unsigned pw;
    { const int sq = tid >> 7; const bf16_t* sp = HYT + (size_t)((sq & 1) ? 2 * DH + c : c) * NTOK + (size_t)(2 * pr_lo + (sq >> 1)) * SEQ; pw = *(const unsigned*)((const char*)sp + (tid & 127) * 128); }
    fft_pass16<16384, -1, 0>(z, tid); __syncthreads(); fft_pass32<-1>(z, tid); __syncthreads();
    if (pw == 0x9e3779b9u) red[9] = 1.f;
    v2 kh[32];
    ld32(z, tid, kh); dft32<-1>(kh);
    const float* cw = p.in[3]; const float* cb = p.in[4];
    const float wv0 = cw[c], wv1 = cw[2304 + c], wv2 = cw[4608 + c], bv = cb[c];
    const float wa0 = cw[DH + c], wa1 = cw[2304 + DH + c], wa2 = cw[4608 + DH + c], ba = cb[DH + c];
    const float wb0 = cw[2 * DH + c], wb1 = cw[2304 + 2 * DH + c], wb2 = cw[4608 + 2 * DH + c], bbq = cb[2 * DH + c];
    const float dskip = p.in[15][c];
    const bf16_t* sv = HYT + (size_t)c * NTOK; const bf16_t* sx0 = HYT + (size_t)(DH + c) * NTOK; const bf16_t* sx1 = HYT + (size_t)(2 * DH + c) * NTOK;
#pragma unroll 1
    for (int pr = pr_lo; pr < pr_hi; ++pr) {
        const size_t o0 = (size_t)(2 * pr) * SEQ, o1 = o0 + SEQ;
        int tl = tid; asm volatile("" : "+v"(tl));
        unsigned uu[16];
        __syncthreads();
#pragma unroll
        for (int hh = 0; hh < 2; ++hh) { In6 a[2], b[2], cc[2], d[2];
#pragma unroll
          for (int i2 = 0; i2 < 2; ++i2) { const int it = 2 * hh + i2; const int l4 = (tl + 512 * it) * 4; a[i2] = ld6(sv + o0, l4); b[i2] = ld6(sx1 + o0, l4); cc[i2] = ld6(sv + o1, l4); d[i2] = ld6(sx1 + o1, l4); }
#pragma unroll
          for (int i2 = 0; i2 < 2; ++i2) { const int it = 2 * hh + i2; const int l4 = (tl + 512 * it) * 4; float v0[4], x10[4], v1[4], x11[4];
              conv3(a[i2], wv0, wv1, wv2, bv, v0); conv3(b[i2], wb0, wb1, wb2, bbq, x10); conv3(cc[i2], wv0, wv1, wv2, bv, v1); conv3(d[i2], wb0, wb1, wb2, bbq, x11);
#pragma unroll
              for (int s = 0; s < 4; ++s) { v0[s] *= x10[s]; v1[s] *= x11[s]; uu[4 * it + s] = pk(v0[s], v1[s]); }
              float4* dd = (float4*)(z + phys(l4));
              dd[0] = make_float4(v0[0], v1[0], v0[1], v1[1]); dd[1] = make_float4(v0[2], v1[2], v0[3], v1[3]); }
          __builtin_amdgcn_sched_barrier(0); }
        __syncthreads();
        fft_pass16<16384, -1, 1>(z, tid); __syncthreads(); fft_pass32<-1>(z, tid); __syncthreads();
        { v2 x[32]; ld32(z, tl, x); dft32<-1>(x);
#pragma unroll
          for (int r = 0; r < 32; ++r) x[r] = cmulv(x[r], kh[r]);
          dft32<1>(x); st32(z, tl, x); }
        __syncthreads();
        unsigned pf0, pf1;
        { const size_t on = (pr + 1 < pr_hi) ? o0 + 2 * SEQ : o0; const int sq = tid >> 7;
          const bf16_t* sp = ((sq & 1) ? sx1 : sv) + on + (sq >> 1) * SEQ; pf0 = *(const unsigned*)((const char*)sp + (tid & 127) * 128);
          const bf16_t* sp2 = sx0 + o0 + (sq & 1) * SEQ; pf1 = *(const unsigned*)((const char*)sp2 + (tid & 127) * 128); }
        fft_pass32<1>(z, tid); __syncthreads();
        fft_pass16<16384, 1, 1>(z, tid);
        In6 ea[4], eb[4];
#pragma unroll
        for (int it = 0; it < 4; ++it) { const int l4 = (tl + 512 * it) * 4; ea[it] = ld6(sx0 + o0, l4); eb[it] = ld6(sx0 + o1, l4); }
        __syncthreads();
#pragma unroll
        for (int it = 0; it < 4; ++it) { const int l4 = (tl + 512 * it) * 4; float x00[4], x01[4];
            conv3(ea[it], wa0, wa1, wa2, ba, x00); conv3(eb[it], wa0, wa1, wa2, ba, x01);
            const float4* s = (const float4*)(z + phys(l4)); const float4 a = s[0], b = s[1];
            const float cv0[4] = {a.x, a.z, b.x, b.z}, cv1[4] = {a.y, a.w, b.y, b.w};
            float y0[4], y1[4];
#pragma unroll
            for (int s4 = 0; s4 < 4; ++s4) { y0[s4] = x00[s4] * (cv0[s4] + dskip * bflo(uu[4 * it + s4])); y1[s4] = x01[s4] * (cv1[s4] + dskip * bfhi(uu[4 * it + s4])); }
            uint2 w0; w0.x = pk(y0[0], y0[1]); w0.y = pk(y0[2], y0[3]); uint2 w1; w1.x = pk(y1[0], y1[1]); w1.y = pk(y1[2], y1[3]);
            *(uint2*)(YHT + (size_t)c * NTOK + o0 + l4) = w0; *(uint2*)(YHT + (size_t)c * NTOK + o1 + l4) = w1; }
        if ((pf0 ^ pf1) == 0x9e3779b9u) red[8] = 1.f;
    }
}
__device__ void lru_unit(const Params& p, unsigned char* lds, int unit) {
    int tid = threadIdx.x; asm volatile("" : "+v"(tid)); const int lane = tid & 63, wid = __builtin_amdgcn_readfirstlane(tid >> 6);
    const int dir = unit / 96, rem = unit % 96, b = rem / 12, h = rem % 12;
    bf16_t* INs = (bf16_t*)lds + wid * (20 * 64);
    bf16_t* XB = (bf16_t*)(lds + 20480);
    float* AA = (float*)(lds + 38912);
    float* BB = (float*)(lds + 73728);
    float2* CAR = (float2*)(lds + 108544);
    float* HC = (float*)(lds + 116736);
    uint4* WB = (uint4*)(lds + 117248);
    float* CWL = (float*)(lds + 133632);
    const bf16_t* src = (const bf16_t*)(p.ws + OFF_P2) + (size_t)b * SEQ * 2304 + DH + h * 64;
    bf16_t* dst = (bf16_t*)(p.ws + (dir ? OFF_HB : OFF_HF)) + (size_t)b * SEQ * DH + h * 64;
    const float* wa = p.in[18] + (size_t)(dir * 12 + h) * 4096; const float* wx = p.in[20] + (size_t)(dir * 12 + h) * 4096;
    __syncthreads();
    for (int entry = tid; entry < 1024; entry += 512) { const int f = entry >> 6, ln = entry & 63, g = f >> 3, ct = (f >> 1) & 3, ks = f & 1; const int k0 = 32 * ks + 8 * (ln >> 4), col = 16 * ct + (ln & 15);
        const float* W = g ? wx : wa; float v[8];
#pragma unroll
        for (int e = 0; e < 8; ++e) v[e] = -1.4426950408889634f * W[(k0 + e) * 64 + col];
        uint4 w; w.x = pk(v[0], v[1]); w.y = pk(v[2], v[3]); w.z = pk(v[4], v[5]); w.w = pk(v[6], v[7]); WB[entry] = w; }
    if (tid < 128) HC[tid] = 0.f;
    if (tid < 320) { const int k = tid >> 6, ch = h * 64 + (tid & 63); CWL[tid] = (k < 4) ? p.in[16][k * DH + ch] : p.in[17][ch]; }
    const int oct = lane & 7, rl0 = lane >> 3;
    const int q = dir ? 7 - wid : wid;
    float gba[4], gbx[4], sp8[4];
#pragma unroll
    for (int ct = 0; ct < 4; ++ct) { const int ch = dir * DH + h * 64 + 16 * ct + (lane & 15); gba[ct] = -1.4426950408889634f * p.in[19][ch]; gbx[ct] = -1.4426950408889634f * p.in[21][ch];
        const float e = __expf(-p.in[22][ch]); const float sp = (e < 0.02f) ? e * (1.0f - e * (0.5f - e * (1.0f / 3.0f))) : __logf(1.0f + e); sp8[ct] = 8.0f * 1.4426950408889634f * sp; }
    uint4 R[3];
#define LRU_ISSUE(l0v) { _Pragma("unroll") for (int i = 0; i < 3; ++i) { const int item = lane + 64 * i, r = item >> 3, o = item & 7, l = (l0v) - 1 + 16 * wid + r; const bool ok = (item < 152) && l >= 0 && l < SEQ; \
        R[i] = ok ? *(const uint4*)(src + (size_t)l * 2304 + o * 8) : make_uint4(0u, 0u, 0u, 0u); } }
    LRU_ISSUE(dir ? SEQ - 128 : 0)
    __syncthreads();
    float cwr[5][8];
#pragma unroll
    for (int k = 0; k < 5; ++k) { const float4 c0 = *(const float4*)(CWL + k * 64 + oct * 8), c1 = *(const float4*)(CWL + k * 64 + oct * 8 + 4);
        cwr[k][0] = c0.x; cwr[k][1] = c0.y; cwr[k][2] = c0.z; cwr[k][3] = c0.w; cwr[k][4] = c1.x; cwr[k][5] = c1.y; cwr[k][6] = c1.z; cwr[k][7] = c1.w; }
#pragma unroll 1
    for (int T = 0; T < 64; ++T) {
        const int l0 = dir ? SEQ - 128 * (T + 1) : 128 * T;
#pragma unroll
        for (int i = 0; i < 3; ++i) { const int item = lane + 64 * i; if (item < 160) *(uint4*)(INs + (item >> 3) * 64 + (item & 7) * 8) = R[i]; }
        asm volatile("" ::: "memory");
        if (T + 1 < 64) LRU_ISSUE(dir ? SEQ - 128 * (T + 2) : 128 * (T + 1))
#pragma unroll
        for (int i = 0; i < 2; ++i) { const int rl = rl0 + 8 * i; float acc[8];
#pragma unroll
            for (int e = 0; e < 8; ++e) acc[e] = cwr[4][e];
#pragma unroll
            for (int k = 0; k < 4; ++k) { const uint4 w = *(const uint4*)(INs + (rl + k) * 64 + oct * 8);
                acc[0] += cwr[k][0] * bflo(w.x); acc[1] += cwr[k][1] * bfhi(w.x); acc[2] += cwr[k][2] * bflo(w.y); acc[3] += cwr[k][3] * bfhi(w.y);
                acc[4] += cwr[k][4] * bflo(w.z); acc[5] += cwr[k][5] * bfhi(w.z); acc[6] += cwr[k][6] * bflo(w.w); acc[7] += cwr[k][7] * bfhi(w.w); }
            uint4 o; o.x = pk(acc[0], acc[1]); o.y = pk(acc[2], acc[3]); o.z = pk(acc[4], acc[5]); o.w = pk(acc[6], acc[7]);
            *(uint4*)(XB + (16 * wid + rl) * 72 + oct * 8) = o; }
        asm volatile("" ::: "memory");
        { const int rowA = 16 * wid + (lane & 15);
          const bf16x8_t a0 = *(const bf16x8_t*)(XB + rowA * 72 + 8 * (lane >> 4)), a1 = *(const bf16x8_t*)(XB + rowA * 72 + 32 + 8 * (lane >> 4));
          const int firstrow = dir ? 127 : 0;
#pragma unroll
          for (int ct = 0; ct < 4; ++ct) {
              f32x4_t accA = {gba[ct], gba[ct], gba[ct], gba[ct]}, accX = {gbx[ct], gbx[ct], gbx[ct], gbx[ct]};
              const uint4 b0 = WB[((0 * 4 + ct) * 2 + 0) * 64 + lane], b1 = WB[((0 * 4 + ct) * 2 + 1) * 64 + lane], b2 = WB[((1 * 4 + ct) * 2 + 0) * 64 + lane], b3 = WB[((1 * 4 + ct) * 2 + 1) * 64 + lane];
              accA = __builtin_amdgcn_mfma_f32_16x16x32_bf16(a0, __builtin_bit_cast(bf16x8_t, b0), accA, 0, 0, 0);
              accA = __builtin_amdgcn_mfma_f32_16x16x32_bf16(a1, __builtin_bit_cast(bf16x8_t, b1), accA, 0, 0, 0);
              accX = __builtin_amdgcn_mfma_f32_16x16x32_bf16(a0, __builtin_bit_cast(bf16x8_t, b2), accX, 0, 0, 0);
              accX = __builtin_amdgcn_mfma_f32_16x16x32_bf16(a1, __builtin_bit_cast(bf16x8_t, b3), accX, 0, 0, 0);
              const int ch = 16 * ct + (lane & 15);
#pragma unroll
              for (int j = 0; j < 4; ++j) { const int row = 16 * wid + 4 * (lane >> 4) + j;
                  const float r = __builtin_amdgcn_rcpf(1.0f + __builtin_amdgcn_exp2f(accA[j])), ig = __builtin_amdgcn_rcpf(1.0f + __builtin_amdgcn_exp2f(accX[j]));
                  const float a = __builtin_amdgcn_exp2f(-sp8[ct] * r); float mult = __builtin_amdgcn_sqrtf(fmaxf(1.0f - a * a, 0.f));
                  if (T == 0 && row == firstrow) mult = 1.0f;
                  const float xbv = bf2f(XB[row * 72 + ch]);
                  AA[row * 68 + ch] = a; BB[row * 68 + ch] = mult * ig * xbv; } } }
        asm volatile("" ::: "memory");
        { float av[16], bv[16]; float P = 1.f, H = 0.f;
#pragma unroll
          for (int s = 0; s < 16; ++s) { const int row = 16 * wid + (dir ? 15 - s : s); av[s] = AA[row * 68 + lane]; bv[s] = BB[row * 68 + lane]; H = av[s] * H + bv[s]; P *= av[s]; }
          CAR[((T & 1) * 8 + q) * 64 + lane] = make_float2(P, H);
          __syncthreads();
          float hin = HC[(T & 1) * 64 + lane];
          for (int s2 = 0; s2 < q; ++s2) { const float2 c2 = CAR[((T & 1) * 8 + s2) * 64 + lane]; hin = c2.x * hin + c2.y; }
#pragma unroll
          for (int s = 0; s < 16; ++s) { const int row = 16 * wid + (dir ? 15 - s : s); hin = av[s] * hin + bv[s]; dst[(size_t)(l0 + row) * DH + lane] = (bf16_t)(pk(hin, hin) & 0xffffu); }
          if (q == 7) HC[((T + 1) & 1) * 64 + lane] = hin; }
    }
#undef LRU_ISSUE
}
__device__ void phase_mix(const Params& p, unsigned char* lds, int which, int skip = 0) {
    unsigned* ctr = (unsigned*)(p.ws + OFF_CTL) + which; volatile int* slot = (volatile int*)(lds + LDS_BYTES - 16);
    for (;;) {
        __syncthreads();
        if (threadIdx.x == 0) *slot = (int)atomicAdd(ctr, 1u);
        __syncthreads();
        const int u = __builtin_amdgcn_readfirstlane(*slot);
        if (u >= N_LRU_UNITS + N_HY_FULL + 2 * (N_HY_UNITS - N_HY_FULL)) break;
        if (u < N_LRU_UNITS) { if (skip != 1) lru_unit(p, lds, u); }
        else if (skip != 2) { const int v = u - N_LRU_UNITS;
            if (v < N_HY_FULL) hyena_unit(p, lds, v, 0, 4);
            else { const int w = v - N_HY_FULL; hyena_unit(p, lds, N_HY_FULL + (w >> 1), (w & 1) * 2, (w & 1) * 2 + 2); } }
    }
}
__device__ void phase_ycat(const Params& p, unsigned char* lds) {
    const int tid = threadIdx.x, lane = tid & 63, wid = tid >> 6;
    unsigned* T = (unsigned*)lds; const unsigned short* Th = (const unsigned short*)lds;
    const bf16_t* YHT = (const bf16_t*)(p.ws + OFF_YHT); const bf16_t* P2 = (const bf16_t*)(p.ws + OFF_P2);
    const bf16_t* HF = (const bf16_t*)(p.ws + OFF_HF); const bf16_t* HB = (const bf16_t*)(p.ws + OFF_HB); bf16_t* YC = (bf16_t*)(p.ws + OFF_YCAT);
    float hg[12], lg[12];
#pragma unroll
    for (int m = 0; m < 6; ++m) { hg[2 * m] = p.in[23][2 * lane + 128 * m]; hg[2 * m + 1] = p.in[23][2 * lane + 128 * m + 1]; }
#pragma unroll
    for (int m = 0; m < 3; ++m)
#pragma unroll
        for (int e = 0; e < 4; ++e) lg[4 * m + e] = p.in[24][4 * lane + 256 * m + e];
    uint4 yt[12];
    { const int tok0 = blockIdx.x * 64;
#pragma unroll
      for (int i = 0; i < 12; ++i) { const int idx = tid + 512 * i, c = idx >> 3, seg = idx & 7; yt[i] = (blockIdx.x < NTOK / 64) ? *(const uint4*)(YHT + (size_t)c * NTOK + tok0 + seg * 8) : make_uint4(0u, 0u, 0u, 0u); } }
    for (int tile = blockIdx.x; tile < NTOK / 64; tile += gridDim.x) {
        const int tok0 = tile * 64;
        __syncthreads();
#pragma unroll
        for (int i = 0; i < 12; ++i) { const int idx = tid + 512 * i, c = idx >> 3, seg = idx & 7; unsigned* d = T + c * 33 + seg * 4; d[0] = yt[i].x; d[1] = yt[i].y; d[2] = yt[i].z; d[3] = yt[i].w; }
        __syncthreads();
        { const int ntile = tile + gridDim.x; const int tokn = (ntile < NTOK / 64 ? ntile : tile) * 64;
#pragma unroll
          for (int i = 0; i < 12; ++i) { const int idx = tid + 512 * i, c = idx >> 3, seg = idx & 7; yt[i] = *(const uint4*)(YHT + (size_t)c * NTOK + tokn + seg * 8); } }
        unsigned gh[2][6]; uint2 hf[2][3], hb[2][3], gl[2][3];
#define YC_ISSUE(slot, ii) { const size_t tk = (size_t)tok0 + 8 * wid + (ii); \
            _Pragma("unroll") for (int m = 0; m < 6; ++m) gh[slot][m] = *(const unsigned*)(P2 + tk * 2304 + 2 * lane + 128 * m); \
            _Pragma("unroll") for (int m = 0; m < 3; ++m) { const int c = 4 * lane + 256 * m; hf[slot][m] = *(const uint2*)(HF + tk * DH + c); hb[slot][m] = *(const uint2*)(HB + tk * DH + c); gl[slot][m] = *(const uint2*)(P2 + tk * 2304 + 1536 + c); } }
        YC_ISSUE(0, 0)
#pragma unroll
        for (int i = 0; i < 8; ++i) { const int t = 8 * wid + i; const size_t tok = (size_t)tok0 + t; const int cs = i & 1, ns = cs ^ 1;
            if (i < 7) YC_ISSUE(ns, i + 1)
            float y[12]; float ss = 0.f;
#pragma unroll
            for (int m = 0; m < 6; ++m) { const int c = 2 * lane + 128 * m; y[2 * m] = bf2f(Th[c * 66 + t]); y[2 * m + 1] = bf2f(Th[(c + 1) * 66 + t]); ss += y[2 * m] * y[2 * m] + y[2 * m + 1] * y[2 * m + 1]; }
            ss = wave_sum(ss); const float rs = rsqrtf(ss * (1.0f / DH) + 1e-6f);
#pragma unroll
            for (int m = 0; m < 6; ++m) { const int c = 2 * lane + 128 * m; const unsigned gw = gh[cs][m]; const float g0 = bflo(gw), g1 = bfhi(gw);
                const float o0 = y[2 * m] * rs * hg[2 * m] * (g0 * sigm(g0)), o1 = y[2 * m + 1] * rs * hg[2 * m + 1] * (g1 * sigm(g1));
                *(unsigned*)(YC + tok * 1536 + c) = pk(o0, o1); }
            float q[12]; float s2 = 0.f;
#pragma unroll
            for (int m = 0; m < 3; ++m) { const uint2 f = hf[cs][m], bq = hb[cs][m];
                q[4 * m] = bflo(f.x) + bflo(bq.x); q[4 * m + 1] = bfhi(f.x) + bfhi(bq.x); q[4 * m + 2] = bflo(f.y) + bflo(bq.y); q[4 * m + 3] = bfhi(f.y) + bfhi(bq.y);
                s2 += q[4 * m] * q[4 * m] + q[4 * m + 1] * q[4 * m + 1] + q[4 * m + 2] * q[4 * m + 2] + q[4 * m + 3] * q[4 * m + 3]; }
            s2 = wave_sum(s2); const float rs2 = rsqrtf(s2 * (1.0f / DH) + 1e-6f);
#pragma unroll
            for (int m = 0; m < 3; ++m) { const int c = 4 * lane + 256 * m; const uint2 gw = gl[cs][m];
                const float g0 = bflo(gw.x), g1 = bfhi(gw.x), g2 = bflo(gw.y), g3 = bfhi(gw.y);
                uint2 o; o.x = pk(q[4 * m] * rs2 * lg[4 * m] * (g0 * sigm(g0)), q[4 * m + 1] * rs2 * lg[4 * m + 1] * (g1 * sigm(g1)));
                o.y = pk(q[4 * m + 2] * rs2 * lg[4 * m + 2] * (g2 * sigm(g2)), q[4 * m + 3] * rs2 * lg[4 * m + 3] * (g3 * sigm(g3)));
                *(uint2*)(YC + tok * 1536 + DH + c) = o; }
        }
#undef YC_ISSUE
    }
}
__device__ void phase_final(const Params& p) {
    const int tid = threadIdx.x, lane = tid & 63, wid = tid >> 6;
    const float4* g4 = (const float4*)p.in[26]; float4 gv[4];
#pragma unroll
    for (int i = 0; i < 4; ++i) gv[i] = g4[i * 64 + lane];
    for (int row = blockIdx.x * 8 + wid; row < NTOK; row += gridDim.x * 8) {
        float4* src = (float4*)(p.out + (size_t)row * DM);
        float4 v[4]; float ss = 0.f;
#pragma unroll
        for (int i = 0; i < 4; ++i) { v[i] = src[i * 64 + lane]; ss += v[i].x * v[i].x + v[i].y * v[i].y + v[i].z * v[i].z + v[i].w * v[i].w; }
        ss = wave_sum(ss);
        const float rs = rsqrtf(ss * (1.0f / DM) + 1e-6f);
#pragma unroll
        for (int i = 0; i < 4; ++i) src[i * 64 + lane] = make_float4(v[i].x * rs * gv[i].x, v[i].y * rs * gv[i].y, v[i].z * rs * gv[i].z, v[i].w * rs * gv[i].w);
    }
}

#define XB_TMO      128
#define XB_XCNT(j)  (256  + 64 * (j))
#define XB_XSUB(j)  (1280 + 64 * (j))
#define XB_XGEN(j)  (2304 + 64 * (j))
#define XB_TOP      3328
#define XB_TOPGEN   3392
#define XCD_BAR_WORDS 3456
#define XB_SPIN_CAP (1u << 18)
#define LAS __attribute__((address_space(3)))

__device__ __forceinline__ unsigned xb_ld(unsigned* p)              { return __hip_atomic_load(p, __ATOMIC_RELAXED, __HIP_MEMORY_SCOPE_AGENT); }
__device__ __forceinline__ unsigned xb_add(unsigned* p, unsigned v) { return __hip_atomic_fetch_add(p, v, __ATOMIC_RELAXED, __HIP_MEMORY_SCOPE_AGENT); }
__device__ __forceinline__ unsigned xb_xcc_id() { return (unsigned)__builtin_amdgcn_s_getreg((3 << 11) | 20) & 0xFu; }
#define XB_SPIN(cond, bar) do { unsigned _sp = 0; while (cond) { __builtin_amdgcn_s_sleep(1); \
    if ((++_sp & 255u) == 0u) { if (xb_ld(&(bar)[XB_TMO])) break; if (_sp > XB_SPIN_CAP) { atomicAdd(&(bar)[XB_TMO], 1u); break; } } } } while (0)

struct XcdBarrier {
    unsigned* bar; unsigned x;
    volatile LAS unsigned* st;
};

__device__ __forceinline__ XcdBarrier xcd_barrier_post(unsigned* bar, volatile LAS unsigned* st) {
    XcdBarrier b; b.bar = bar; b.x = xb_xcc_id(); b.st = st;
    if (threadIdx.x == 0) (void)xb_add(&bar[XB_XCNT(b.x)], 1u);
    return b;
}
__device__ __forceinline__ void xcd_barrier_complete(unsigned* bar, unsigned x, unsigned& nloc, unsigned& nx) {
    const unsigned G = gridDim.x * gridDim.y * gridDim.z;
    unsigned sum, cnt, mine, sp = 0u;
    for (;;) {
        sum = 0u; cnt = 0u; mine = 0u;
#pragma unroll
        for (unsigned j = 0; j < 16; ++j) { const unsigned c = xb_ld(&bar[XB_XCNT(j)]); sum += c; cnt += (c > 0u) ? 1u : 0u; mine = (j == x) ? c : mine; }
        if (sum == G) break;
        __builtin_amdgcn_s_sleep(1);
        if ((++sp & 255u) == 0u) { if (xb_ld(&bar[XB_TMO])) break; if (sp > XB_SPIN_CAP) { atomicAdd(&bar[XB_TMO], 1u); break; } }
    }
    nloc = mine > 0u ? mine : 1u; nx = cnt > 0u ? cnt : 1u;
}

__device__ __forceinline__ void xcd_barrier(const XcdBarrier& b) {
    asm volatile("s_waitcnt vmcnt(0)" ::: "memory");
    __syncthreads();
    if (threadIdx.x == 0) {
        unsigned* bar = b.bar;
        __builtin_amdgcn_s_waitcnt(0);
        unsigned nloc = b.st[0], nx = b.st[1];
        if (nloc == 0u) { xcd_barrier_complete(bar, b.x, nloc, nx); b.st[0] = nloc; b.st[1] = nx; }
        const unsigned old = xb_add(&bar[XB_XSUB(b.x)], 1u);
        const unsigned gen = old / nloc;
        if (old + 1u == (gen + 1u) * nloc) {
            __builtin_amdgcn_fence(__ATOMIC_RELEASE, "agent");
            asm volatile("s_waitcnt vmcnt(0)" ::: "memory");
            const unsigned og = xb_add(&bar[XB_TOP], 1u);
            const unsigned tg = og / nx;
            if (og + 1u == (tg + 1u) * nx) xb_add(&bar[XB_TOPGEN], 1u);
            else XB_SPIN(xb_ld(&bar[XB_TOPGEN]) == tg, bar);
            __builtin_amdgcn_fence(__ATOMIC_ACQUIRE, "agent");
            xb_add(&bar[XB_XGEN(b.x)], 1u);
            asm volatile("s_waitcnt vmcnt(0)" ::: "memory");
        } else {
            XB_SPIN(xb_ld(&bar[XB_XGEN(b.x)]) == gen, bar);
            __builtin_amdgcn_fence(__ATOMIC_ACQUIRE, "agent");
            asm volatile("s_waitcnt vmcnt(0)" ::: "memory");
        }
    }
    __syncthreads();
}

constexpr int N_PHASES = 5;
__global__ void __launch_bounds__(512) hymba_fwd(Params p) {
    extern __shared__ __attribute__((aligned(16))) unsigned char lds[];
    cg::grid_group grid = cg::this_grid();
#ifndef ONLY_PHASE
#define ONLY_PHASE -1
#endif
#define PH_ON(n) (ONLY_PHASE < 0 || ONLY_PHASE == (n))
#ifndef DUP_SKIP
#define DUP_SKIP 0
#endif
#ifndef DUP_PHASE
#define DUP_PHASE -1
#endif
    const int lo = p.ph_lo, hi = p.ph_hi;
    volatile LAS unsigned* xst = (volatile LAS unsigned*)((LAS unsigned char*)lds + (LDS_BYTES - 32));
    if (threadIdx.x == 0) { xst[0] = 0u; xst[1] = 0u; }
    __syncthreads();
    const XcdBarrier xb = xcd_barrier_post((unsigned*)(p.ws + OFF_XBAR), xst);
    if (hi > 1000) grid.sync();
    if (lo <= 0 && 0 < hi) { if (PH_ON(0)) phase0(p, lds); if (DUP_PHASE == 0) { grid.sync(); phase0(p, lds); } }
    if (lo <= 1 && 1 < hi) { if (lo < 1) xcd_barrier(xb); if (PH_ON(1)) phase_gemm1(p, lds); if (DUP_PHASE == 1) { grid.sync(); phase_gemm1(p, lds); } }
    if (lo <= 2 && 2 < hi) { if (lo < 2) xcd_barrier(xb); if (PH_ON(2)) phase_mix(p, lds, 0, MIX_SEL); if (DUP_PHASE == 2) { grid.sync(); phase_mix(p, lds, 1, DUP_SKIP); } }
    if (lo <= 3 && 3 < hi) { if (lo < 3) xcd_barrier(xb); if (PH_ON(3)) phase_ycat(p, lds); if (DUP_PHASE == 3) { grid.sync(); phase_ycat(p, lds); } }
    if (lo <= 4 && 4 < hi) { if (lo < 4) xcd_barrier(xb); if (PH_ON(4)) phase_gemm2(p, lds); if (DUP_PHASE == 4) { grid.sync(); phase_gemm2(p, lds); } }
}
extern "C" void kernel_launch(void* const* d_in, const int* in_sizes, int n_in, void* d_out, int out_size, void* d_ws, size_t ws_size, hipStream_t stream) {
    static int grid = 0;
    if (grid == 0) {
        if (n_in != 27 || ws_size < WS_END) { fprintf(stderr, "kernel_launch: expected 27 inputs and >= %zu bytes of workspace (got %d, %zu)\n", (size_t)WS_END, n_in, ws_size); grid = -1; return; }
        int dev = 0, cus = 0, per_cu = 0;
        hipGetDevice(&dev); hipDeviceGetAttribute(&cus, hipDeviceAttributeMultiprocessorCount, dev);
        if (hipFuncSetAttribute((const void*)hymba_fwd, hipFuncAttributeMaxDynamicSharedMemorySize, LDS_BYTES) != hipSuccess) { fprintf(stderr, "kernel_launch: hipFuncSetAttribute failed\n"); grid = -1; return; }
        if (hipOccupancyMaxActiveBlocksPerMultiprocessor(&per_cu, (const void*)hymba_fwd, 512, LDS_BYTES) != hipSuccess || per_cu < 1) { fprintf(stderr, "kernel_launch: occupancy query failed (%d)\n", per_cu); (void)hipGetLastError(); grid = -1; return; }
        grid = cus * per_cu; if (grid > 256) grid = 256; grid &= ~3;
    }
    if (grid < 0) return;
    hipMemsetAsync((char*)d_ws + OFF_CTL, 0, 32768, stream);
    Params p{};
    for (int i = 0; i < 27; ++i) p.in[i] = (const float*)d_in[i];
    p.out = (float*)d_out; p.ws = (unsigned char*)d_ws;
    const int per = (N_PHASES + MK_N_LAUNCHES - 1) / MK_N_LAUNCHES;
    for (int lo = 0; lo < N_PHASES; lo += per) {
        p.ph_lo = lo; p.ph_hi = lo + per < N_PHASES ? lo + per : N_PHASES;
        void* args[] = {&p};
        const hipError_t e = hipLaunchCooperativeKernel((const void*)hymba_fwd, dim3(grid), dim3(512), args, LDS_BYTES, stream);
        if (e != hipSuccess) { fprintf(stderr, "kernel_launch: cooperative launch failed: %s (grid %d)\n", hipGetErrorString(e), grid); break; }
    }
}
```

```cpp
#include <hip/hip_runtime.h>
#include <hip/hip_cooperative_groups.h>
#include <cstdio>
namespace cg = cooperative_groups;
#ifndef MK_N_LAUNCHES
#define MK_N_LAUNCHES 1
#endif
namespace pg8 {
#define PG8_LAS __attribute__((address_space(3)))
typedef unsigned short bf16_t;
typedef short bf16x8 __attribute__((ext_vector_type(8)));
typedef float f32x4 __attribute__((ext_vector_type(4)));
typedef unsigned u32x4 __attribute__((ext_vector_type(4)));
constexpr int BM = 256, BK = 64, HALF = 128, HTB = HALF * BK * 2  , STAGE_BYTES = 8 * HTB, NXCD = 8, WGM = 8;

__host__ __device__ __forceinline__ int lds_byte(int r, int c) { const int st = (r >> 4) * 2 + (c >> 5), rr = r & 15, cc = c & 31, ob = rr * 64 + cc * 2; return st * 1024 + (ob ^ (((ob >> 9) & 1) << 5)); }
__host__ __device__ __forceinline__ void stage_rc(int b, int& R, int& C) { const int st = b / 1024, sb = b % 1024, swz = sb ^ (((sb >> 9) & 1) << 5); R = (st >> 1) * 16 + swz / 64; C = (st & 1) * 32 + (swz % 64) / 2; }
__host__ __device__ __forceinline__ int perm32(int rho) { const int n = rho >> 4, i = rho & 15; return 8 * (i >> 2) + 4 * n + (i & 3); }

struct Unit { int pm, pn; };
struct Gemm { const bf16_t* A; const bf16_t* Bt; int M, N, K; };

struct StaticOrder {
    int nM, nN, nwg, G, c;
    __host__ __device__ void init(int M, int N, int G_, int c_) { nM = M / BM; nN = N / BM; nwg = nM * nN; G = G_; c = c_; }
    __host__ __device__ bool next(int i, Unit& u) const {
        const long L = (long)i * G + c; if (L >= nwg) return false;
        int wgid = (int)L; { const int q = nwg / NXCD, r = nwg % NXCD, xcd = wgid % NXCD, off = wgid / NXCD; wgid = (xcd < r ? xcd * (q + 1) : r * (q + 1) + (xcd - r) * q) + off; }
        const int nig = WGM * nN, gid = wgid / nig, fm = gid * WGM, gsz = (nM - fm) < WGM ? (nM - fm) : WGM;
        u.pm = fm + ((wgid % nig) % gsz); u.pn = (wgid % nig) / gsz; return true;
    }
    __device__ __forceinline__ void a_ready(const Unit&) const {}
    __device__ __forceinline__ void done(const Unit&) const {}
};
__device__ __forceinline__ unsigned cvt_pk_bf16(float lo, float hi) { unsigned r; asm volatile("v_cvt_pk_bf16_f32 %0, %1, %2" : "=v"(r) : "v"(lo), "v"(hi)); return r; }
typedef float f32x2 __attribute__((ext_vector_type(2)));

struct EpiStoreBf16 {
    static constexpr bool PERM = true, AFTER_DRAIN = false;
    bf16_t* O; int ldc;
    __device__ __forceinline__ void operator()(const f32x4 (&acc)[2][2][4][2], const Unit& u, int wr, int wc, int fr, int fq) const {
        const int row0 = u.pm * BM + wr * 64 + fr; const int col0 = u.pn * BM + wc * 32 + 8 * fq;
#pragma unroll
        for (int ai = 0; ai < 2; ++ai)
#pragma unroll
            for (int m = 0; m < 4; ++m) { bf16_t* rowp = O + (size_t)(row0 + ai * HALF + m * 16) * ldc + col0;
#pragma unroll
                for (int bj = 0; bj < 2; ++bj) { const f32x4 v0 = acc[ai][bj][m][0], v1 = acc[ai][bj][m][1];
                    u32x4 w; w.x = cvt_pk_bf16(v0[0], v0[1]); w.y = cvt_pk_bf16(v0[2], v0[3]); w.z = cvt_pk_bf16(v1[0], v1[1]); w.w = cvt_pk_bf16(v1[2], v1[3]);
                    *(u32x4*)(rowp + bj * HALF) = w; } }
    }
};
struct EpiResidF32 {
    static constexpr bool PERM = false, AFTER_DRAIN = false;
    float* C; const float* X; int ldc;
    __device__ __forceinline__ void operator()(const f32x4 (&acc)[2][2][4][2], const Unit& u, int wr, int wc, int fr, int fq) const {
        const int row0 = u.pm * BM + wr * 64 + fr, col0 = u.pn * BM + wc * 32 + 4 * fq;
#pragma unroll
        for (int ai = 0; ai < 2; ++ai)
#pragma unroll
            for (int m = 0; m < 4; ++m) { const size_t off = (size_t)(row0 + ai * HALF + m * 16) * ldc + col0;
#pragma unroll
                for (int bj = 0; bj < 2; ++bj)
#pragma unroll
                    for (int n = 0; n < 2; ++n) { const f32x4 xv = *(const f32x4*)(X + off + bj * HALF + n * 16); *(f32x4*)(C + off + bj * HALF + n * 16) = acc[ai][bj][m][n] + xv; } }
    }
};
struct OneUnit {
    int pm, pn;
    __device__ __forceinline__ bool next(int i, Unit& u) const { if (i) return false; u.pm = pm; u.pn = pn; return true; }
    __device__ __forceinline__ void a_ready(const Unit&) const {}
    __device__ __forceinline__ void done(const Unit&) const {}
};
struct EpiFinal {
    static constexpr bool PERM = false, AFTER_DRAIN = true;
    float* C; const float* X; const float* G; float* rowsq; unsigned* cnt;
    __device__ __forceinline__ void fused(f32x4 (&acc)[2][2][4][2], const Unit& u, int wr, int wc, int fr, int fq, PG8_LAS unsigned char* lds, int wid, int lane) const {
        PG8_LAS float* P = (PG8_LAS float*)lds;
        PG8_LAS float* S = (PG8_LAS float*)(lds + 4096);
        const int tid = wid * 64 + lane;
        const int row0 = u.pm * BM + wr * 64 + fr, col0 = u.pn * BM + wc * 32 + 4 * fq;
#pragma unroll
        for (int ai = 0; ai < 2; ++ai)
#pragma unroll
            for (int m = 0; m < 4; ++m) { const size_t off = (size_t)(row0 + ai * HALF + m * 16) * 1024 + col0; float s = 0.f;
#pragma unroll
                for (int bj = 0; bj < 2; ++bj)
#pragma unroll
                    for (int n = 0; n < 2; ++n) { const f32x4 xv = *(const f32x4*)(X + off + bj * HALF + n * 16); const f32x4 v = acc[ai][bj][m][n] + xv; acc[ai][bj][m][n] = v;
                        s += (v[0] * v[0] + v[1] * v[1]) + (v[2] * v[2] + v[3] * v[3]); }
                s += __shfl_xor(s, 16); s += __shfl_xor(s, 32);
                if (fq == 0) P[(ai * HALF + wr * 64 + m * 16 + fr) * 4 + wc] = s; }
        __syncthreads();
        { float back = 0.f;
          if (tid < 256) { const float tot = (P[tid * 4] + P[tid * 4 + 1]) + (P[tid * 4 + 2] + P[tid * 4 + 3]);
              back = __hip_atomic_fetch_add(rowsq + u.pm * BM + tid, tot, __ATOMIC_RELAXED, __HIP_MEMORY_SCOPE_AGENT); }
          asm volatile("s_waitcnt vmcnt(0)" :: "v"(back) : "memory"); }
        __syncthreads();
        if (tid == 0) {
            __hip_atomic_fetch_add(cnt + u.pm, 1u, __ATOMIC_RELAXED, __HIP_MEMORY_SCOPE_AGENT);
            unsigned sp = 0;
            while (__hip_atomic_load(cnt + u.pm, __ATOMIC_RELAXED, __HIP_MEMORY_SCOPE_AGENT) < 4u) { __builtin_amdgcn_s_sleep(1); if (++sp > (1u << 22)) break; }
        }
        __syncthreads();
        if (tid < 256) S[tid] = __builtin_amdgcn_rsqf(__hip_atomic_load(rowsq + u.pm * BM + tid, __ATOMIC_RELAXED, __HIP_MEMORY_SCOPE_AGENT) * (1.0f / 1024.0f) + 1e-6f);
        __syncthreads();
        f32x4 gv[2][2];
#pragma unroll
        for (int bj = 0; bj < 2; ++bj)
#pragma unroll
            for (int n = 0; n < 2; ++n) gv[bj][n] = *(const f32x4*)(G + col0 + bj * HALF + n * 16);
#pragma unroll
        for (int ai = 0; ai < 2; ++ai)
#pragma unroll
            for (int m = 0; m < 4; ++m) { const size_t off = (size_t)(row0 + ai * HALF + m * 16) * 1024 + col0; const float rs = S[ai * HALF + wr * 64 + m * 16 + fr];
#pragma unroll
                for (int bj = 0; bj < 2; ++bj)
#pragma unroll
                    for (int n = 0; n < 2; ++n) *(f32x4*)(C + off + bj * HALF + n * 16) = acc[ai][bj][m][n] * rs * gv[bj][n]; }
        __syncthreads();
    }
};
template <class Epi, class Sched, bool STAMP = false>
__device__ __forceinline__ void gemm_phase(PG8_LAS unsigned char* lds, const Gemm g, const Sched& S, const Epi& E, unsigned long long* stamps) {
    const int tid = threadIdx.x, wid = __builtin_amdgcn_readfirstlane(tid >> 6), lane = tid & 63, wr = wid >> 2, wc = wid & 3, fr = lane & 15, fq = lane >> 4;
    const int K = g.K, nt = K / BK;
    int ts_lo = 0, ts_hi = 0, nts = 0; const unsigned long long rt_entry = STAMP ? (unsigned long long)wall_clock64() : 0ull;
#define PG8_STAMP() do { if (STAMP && wid == 0 && nts < 64) { const unsigned long long _c = (unsigned long long)clock64(); \
        ts_lo = (lane == nts) ? (int)(unsigned)_c : ts_lo; ts_hi = (lane == nts) ? (int)(unsigned)(_c >> 32) : ts_hi; ++nts; } } while (0)
    PG8_STAMP();
    unsigned voffA[2], voffB[2];
#pragma unroll
    for (int i = 0; i < 2; ++i) { int R, C; stage_rc(tid * 16 + i * 8192, R, C); const int Rb = Epi::PERM ? ((R & ~31) + perm32(R & 31)) : R;
        voffA[i] = (unsigned)(R * K + C) * 2u; voffB[i] = (unsigned)(Rb * K + C) * 2u; }
    const size_t kstep = (size_t)(BK * 2);
    const size_t hstep = (size_t)HALF * K * 2;
    const size_t tstep = 2 * hstep;
    const unsigned ldsw = (unsigned)wid * 1024u;
    const int aoff = lds_byte(wr * 64 + fr, fq * 8), boff = lds_byte(wc * 32 + fr, fq * 8);
#define PG8_SA(b, h) (((b) * 2 + (h)) * HTB)
#define PG8_SB(b, h) ((4 + (b) * 2 + (h)) * HTB)
#define PG8_STAGE(bufoff, gbase, voff) do { _Pragma("unroll") for (int _i = 0; _i < 2; ++_i) \
        __builtin_amdgcn_global_load_lds((const unsigned*)((const char*)(gbase) + (voff)[_i]), (PG8_LAS unsigned*)(lds + (bufoff) + ldsw + _i * 8192), 16, 0, 0); } while (0)
#define PG8_LDA(dst, b, h) do { _Pragma("unroll") for (int m = 0; m < 4; ++m) _Pragma("unroll") for (int k = 0; k < 2; ++k) dst[m][k] = *(const PG8_LAS bf16x8*)(lds + PG8_SA(b, h) + aoff + m * 2048 + k * 1024); } while (0)
#define PG8_LDB(dst, b, h) do { _Pragma("unroll") for (int n = 0; n < 2; ++n) _Pragma("unroll") for (int k = 0; k < 2; ++k) dst[n][k] = *(const PG8_LAS bf16x8*)(lds + PG8_SB(b, h) + boff + n * 2048 + k * 1024); } while (0)
#define PG8_MMA(ai, bj, At, Bt) do { __builtin_amdgcn_s_setprio(1); _Pragma("unroll") for (int m = 0; m < 4; ++m) _Pragma("unroll") for (int n = 0; n < 2; ++n) _Pragma("unroll") for (int k = 0; k < 2; ++k) \
        acc[ai][bj][m][n] = __builtin_amdgcn_mfma_f32_16x16x32_bf16(Bt[n][k], At[m][k], acc[ai][bj][m][n], 0, 0, 0); __builtin_amdgcn_s_setprio(0); } while (0)
#define PG8_WAIT_V(n) asm volatile("s_waitcnt vmcnt(" #n ")" ::: "memory")
#define PG8_WAIT_L(n) asm volatile("s_waitcnt lgkmcnt(" #n ")" ::: "memory")
#define PG8_BAR __builtin_amdgcn_s_barrier()
#define PG8_SCHED __builtin_amdgcn_sched_barrier(0)
    Unit cur, nxt; int ui = 0;
    if (!S.next(0, cur)) return;
    f32x4 acc[2][2][4][2];
#pragma unroll
    for (int a = 0; a < 2; ++a)
#pragma unroll
        for (int b = 0; b < 2; ++b)
#pragma unroll
            for (int m = 0; m < 4; ++m)
#pragma unroll
                for (int n = 0; n < 2; ++n) acc[a][b][m][n] = (f32x4){0.f, 0.f, 0.f, 0.f};
    bf16x8 At[4][2], B0[2][2], B1[2][2];
    const char* cA = (const char*)g.A + (size_t)cur.pm * tstep; const char* cB = (const char*)g.Bt + (size_t)cur.pn * tstep;
    S.a_ready(cur);
    PG8_STAGE(PG8_SB(0, 0), cB, voffB); PG8_STAGE(PG8_SA(0, 0), cA, voffA); PG8_STAGE(PG8_SB(0, 1), cB + hstep, voffB); PG8_STAGE(PG8_SA(0, 1), cA + hstep, voffA);
    if (wr == 1) PG8_BAR;
    PG8_WAIT_V(4); PG8_BAR;
    PG8_STAGE(PG8_SB(1, 0), cB + kstep, voffB); PG8_STAGE(PG8_SA(1, 0), cA + kstep, voffA); PG8_STAGE(PG8_SB(1, 1), cB + hstep + kstep, voffB);
    PG8_WAIT_V(6); PG8_BAR;
    PG8_STAMP();
    for (;;) {
        const bool has_next = S.next(ui + 1, nxt);
        const char* nA = has_next ? (const char*)g.A + (size_t)nxt.pm * tstep : cA; const char* nB = has_next ? (const char*)g.Bt + (size_t)nxt.pn * tstep : cB;
        for (int t = 0; t < nt; t += 2) {
            const bool last = (t == nt - 2);
            const char* a1 = cA + (size_t)(t + 1) * kstep;
            const char* a2 = last ? nA : cA + (size_t)(t + 2) * kstep; const char* b2 = last ? nB : cB + (size_t)(t + 2) * kstep;
            const char* a3 = a2 + kstep; const char* b3 = b2 + kstep;
            if (last && has_next) S.a_ready(nxt);
            PG8_LDB(B0, 0, 0); PG8_SCHED; PG8_LDA(At, 0, 0); PG8_STAGE(PG8_SA(1, 1), a1 + hstep, voffA);
            PG8_WAIT_L(8); PG8_BAR; PG8_WAIT_L(0); PG8_MMA(0, 0, At, B0); PG8_BAR; PG8_SCHED;
            PG8_LDB(B1, 0, 1); PG8_STAGE(PG8_SB(0, 0), b2, voffB);
            PG8_BAR; PG8_WAIT_L(0); PG8_MMA(0, 1, At, B1); PG8_BAR;
            PG8_LDA(At, 0, 1); PG8_STAGE(PG8_SA(0, 0), a2, voffA);
            PG8_BAR; PG8_WAIT_L(0); PG8_MMA(1, 0, At, B0); PG8_BAR; PG8_SCHED;
            PG8_STAGE(PG8_SB(0, 1), b2 + hstep, voffB);
            PG8_WAIT_V(6); PG8_BAR; PG8_MMA(1, 1, At, B1); PG8_BAR;
            PG8_LDB(B0, 1, 0); PG8_SCHED; PG8_LDA(At, 1, 0); PG8_STAGE(PG8_SA(0, 1), a2 + hstep, voffA);
            PG8_WAIT_L(8); PG8_BAR; PG8_WAIT_L(0); PG8_MMA(0, 0, At, B0); PG8_BAR; PG8_SCHED;
            PG8_LDB(B1, 1, 1); PG8_STAGE(PG8_SB(1, 0), b3, voffB);
            PG8_BAR; PG8_WAIT_L(0); PG8_MMA(0, 1, At, B1); PG8_BAR;
            PG8_LDA(At, 1, 1); PG8_STAGE(PG8_SA(1, 0), a3, voffA);
            PG8_BAR; PG8_WAIT_L(0); PG8_MMA(1, 0, At, B0); PG8_BAR; PG8_SCHED;
            PG8_STAGE(PG8_SB(1, 1), b3 + hstep, voffB);
            PG8_WAIT_V(6); PG8_BAR; PG8_MMA(1, 1, At, B1); PG8_BAR;
        }
        PG8_STAMP();
        if constexpr (!Epi::AFTER_DRAIN) { E(acc, cur, wr, wc, fr, fq); S.done(cur); }
        PG8_STAMP();
        if (!has_next) break;
#pragma unroll
        for (int a = 0; a < 2; ++a)
#pragma unroll
            for (int b = 0; b < 2; ++b)
#pragma unroll
                for (int m = 0; m < 4; ++m)
#pragma unroll
                    for (int n = 0; n < 2; ++n) acc[a][b][m][n] = (f32x4){0.f, 0.f, 0.f, 0.f};
        cur = nxt; cA = nA; cB = nB; ++ui;
    }
    PG8_WAIT_V(0);
    if (wr == 0) PG8_BAR;
    PG8_BAR;
    if constexpr (Epi::AFTER_DRAIN) { E.fused(acc, cur, wr, wc, fr, fq, lds, wid, lane); S.done(cur); }
    PG8_STAMP();
    if (STAMP && wid == 0) { stamps[lane] = lane < nts ? (((unsigned long long)(unsigned)ts_hi << 32) | (unsigned)ts_lo) : 0ull;
        if (lane == 62) stamps[62] = rt_entry; if (lane == 63) stamps[63] = (unsigned long long)wall_clock64(); }
#undef PG8_STAMP
#undef PG8_SA
#undef PG8_SB
#undef PG8_STAGE
#undef PG8_LDA
#undef PG8_LDB
#undef PG8_MMA
#undef PG8_WAIT_V
#undef PG8_WAIT_L
#undef PG8_BAR
#undef PG8_SCHED
}
}

using pg8::bf16_t;
typedef short bf16x8_t __attribute__((ext_vector_type(8)));
typedef float f32x4_t __attribute__((ext_vector_type(4)));

constexpr int NB = 8, SEQ = 8192, DM = 1024, DH = 768, NTOK = NB * SEQ;
constexpr size_t MiB = 1ull << 20;
constexpr size_t OFF_XN = 0, OFF_YHT = 0, OFF_HYT = 128 * MiB, OFF_YCAT = 128 * MiB, OFF_P2 = 416 * MiB, OFF_KF = 704 * MiB, OFF_KH = 752 * MiB,
                 OFF_HF = 784 * MiB, OFF_HB = 880 * MiB, OFF_WT1 = 976 * MiB, OFF_WT2 = 985 * MiB, OFF_PS = 988 * MiB, OFF_CTL = 990 * MiB, OFF_XBAR = OFF_CTL + 16384, OFF_CNT = OFF_CTL + 4096, OFF_ROWSQ = OFF_CTL + 65536, WS_END = 991 * MiB;
constexpr int NFFT = 16384;
constexpr int ZPHYS = NFFT + (NFFT / 64) * 4;
constexpr int LDS_BYTES = ZPHYS * 8 + 256;
constexpr int N_LRU_UNITS = 192, N_HY_UNITS = 768, N_HY_FULL = 640;
#ifndef MIX_SEL
#define MIX_SEL 0
#endif

struct Params { const float* in[27]; float* out; unsigned char* ws; int ph_lo, ph_hi; };

__device__ __forceinline__ float bf2f(unsigned short b) { return __uint_as_float(((unsigned)b) << 16); }
__device__ __forceinline__ float bflo(unsigned w) { return __uint_as_float(w << 16); }
__device__ __forceinline__ float bfhi(unsigned w) { return __uint_as_float(w & 0xffff0000u); }
__device__ __forceinline__ unsigned pk(float a, float b) { return pg8::cvt_pk_bf16(a, b); }
__device__ __forceinline__ float wave_sum(float v) {
#pragma unroll
    for (int o = 32; o; o >>= 1) v += __shfl_xor(v, o);
    return v; }
__device__ __forceinline__ float sigm(float x) { return __builtin_amdgcn_rcpf(1.0f + __expf(-x)); }
__device__ __forceinline__ float sin_rad(float x) { const float r = x * 0.15915494309189535f; return __builtin_amdgcn_sinf(r - floorf(r)); }
__device__ __forceinline__ float cos_rad(float x) { const float r = x * 0.15915494309189535f; return __builtin_amdgcn_cosf(r - floorf(r)); }

__device__ void phase_xn(const Params& p) {
    const int tid = threadIdx.x, lane = tid & 63, wid = tid >> 6;
    const float* x = p.in[0]; bf16_t* XN = (bf16_t*)(p.ws + OFF_XN);
    for (int row = (blockIdx.x * 8 + wid) * 4; row < NTOK; row += gridDim.x * 32) {
        float4 v[4][4]; float ss[4];
#pragma unroll
        for (int r = 0; r < 4; ++r) { const float4* src = (const float4*)(x + (size_t)(row + r) * DM);
#pragma unroll
            for (int i = 0; i < 4; ++i) { const f32x4_t t4 = __builtin_nontemporal_load((const f32x4_t*)src + i * 64 + lane); v[r][i] = make_float4(t4[0], t4[1], t4[2], t4[3]); } }
#pragma unroll
        for (int r = 0; r < 4; ++r) { float s = 0.f;
#pragma unroll
            for (int i = 0; i < 4; ++i) s += v[r][i].x * v[r][i].x + v[r][i].y * v[r][i].y + v[r][i].z * v[r][i].z + v[r][i].w * v[r][i].w;
            ss[r] = wave_sum(s); }
#pragma unroll
        for (int r = 0; r < 4; ++r) { const float rs = rsqrtf(ss[r] * (1.0f / DM) + 1e-6f); uint2* dst = (uint2*)(XN + (size_t)(row + r) * DM);
#pragma unroll
            for (int i = 0; i < 4; ++i) { uint2 w; w.x = pk(v[r][i].x * rs, v[r][i].y * rs); w.y = pk(v[r][i].z * rs, v[r][i].w * rs); dst[i * 64 + lane] = w; } }
    }
}
__device__ void transpose_to_bf16(const float* src, int R, int C, const float* rowscale, bf16_t* dst, float* tile) {
    const int tid = threadIdx.x; const int tc = C / 64, nt = (R / 64) * tc;
    for (int t = blockIdx.x; t < nt; t += gridDim.x) {
        const int r0 = (t / tc) * 64, c0 = (t % tc) * 64;
        __syncthreads();
#pragma unroll
        for (int i = 0; i < 2; ++i) { const int r = (tid >> 4) + 32 * i, c4 = (tid & 15) * 4;
            const float4 v = *(const float4*)(src + (size_t)(r0 + r) * C + c0 + c4); const float s = rowscale ? rowscale[r0 + r] : 1.0f;
            tile[r * 65 + c4 + 0] = v.x * s; tile[r * 65 + c4 + 1] = v.y * s; tile[r * 65 + c4 + 2] = v.z * s; tile[r * 65 + c4 + 3] = v.w * s; }
        __syncthreads();
        { const int c = tid >> 3, r8 = (tid & 7) * 8; float v[8];
#pragma unroll
          for (int e = 0; e < 8; ++e) v[e] = tile[(r8 + e) * 65 + c];
          uint4 w; w.x = pk(v[0], v[1]); w.y = pk(v[2], v[3]); w.z = pk(v[4], v[5]); w.w = pk(v[6], v[7]);
          *(uint4*)(dst + (size_t)(c0 + c) * R + r0 + r8) = w; }
    }
}
__device__ void phase_filter(const Params& p, unsigned char* lds) {
    const int tid = threadIdx.x;
    float* Z = (float*)lds; float* H1 = Z + 32 * 33; float* H2 = H1 + 2048; float* H3 = H2 + 2048;
    const float *w1 = p.in[5], *b1 = p.in[6], *f1 = p.in[7], *w2 = p.in[8], *b2 = p.in[9], *f2 = p.in[10], *w3 = p.in[11], *b3 = p.in[12], *f3 = p.in[13], *w4 = p.in[14];
    float* KF = (float*)(p.ws + OFF_KF); float* PS = (float*)(p.ws + OFF_PS);
    const float MIN_DECAY = -15.350567286626973f, MAX_DECAY = -3.0701134573253945f;
    for (int item = blockIdx.x; item < 256; item += gridDim.x) {
        const int j0 = item * 32;
        __syncthreads();
        for (int idx = tid; idx < 32 * 33; idx += 512) { const int row = idx / 33, i = idx % 33, j = j0 + row; float val;
            if (i == 0) val = (float)j * (1.0f / 8191.0f);
            else { const int m = (i - 1) & 15; const float fm = 1e-4f + (float)m * ((15.0f - 1e-4f) / 15.0f); const float wj = (float)j * (6.283185307179586f / 8192.0f); const float xx = wj * fm;
                val = (i <= 16) ? cos_rad(xx) : -sin_rad(xx); }
            Z[idx] = val; }
        __syncthreads();
        { int o = tid & 63; asm volatile("" : "+v"(o)); const int w8 = tid >> 6;
          { float wr[33];
#pragma unroll
            for (int i = 0; i < 33; ++i) wr[i] = w1[i * 64 + o];
            const float bo = b1[o], fo = f1[o];
#pragma unroll 1
            for (int k = 0; k < 4; ++k) { const int row = w8 + 8 * k; float acc = bo;
#pragma unroll
                for (int i = 0; i < 33; ++i) acc += Z[row * 33 + i] * wr[i];
                H1[row * 64 + o] = sin_rad(fo * acc); } }
          __syncthreads();
          { float wr[64];
#pragma unroll
            for (int i = 0; i < 64; ++i) wr[i] = w2[i * 64 + o];
            const float bo = b2[o], fo = f2[o];
#pragma unroll 1
            for (int k = 0; k < 4; ++k) { const int row = w8 + 8 * k; float acc = bo; const float4* h4 = (const float4*)(H1 + row * 64);
#pragma unroll
                for (int i4 = 0; i4 < 16; ++i4) { const float4 hv = h4[i4]; acc += hv.x * wr[4 * i4] + hv.y * wr[4 * i4 + 1] + hv.z * wr[4 * i4 + 2] + hv.w * wr[4 * i4 + 3]; }
                H2[row * 64 + o] = sin_rad(fo * acc); } }
          __syncthreads();
          { float wr[64];
#pragma unroll
            for (int i = 0; i < 64; ++i) wr[i] = w3[i * 64 + o];
            const float bo = b3[o], fo = f3[o];
#pragma unroll 1
            for (int k = 0; k < 4; ++k) { const int row = w8 + 8 * k; float acc = bo; const float4* h4 = (const float4*)(H2 + row * 64);
#pragma unroll
                for (int i4 = 0; i4 < 16; ++i4) { const float4 hv = h4[i4]; acc += hv.x * wr[4 * i4] + hv.y * wr[4 * i4 + 1] + hv.z * wr[4 * i4 + 2] + hv.w * wr[4 * i4 + 3]; }
                ((unsigned short*)H3)[row * 72 + o] = (unsigned short)(pk(sin_rad(fo * acc), 0.f) & 0xffffu); } }
          __syncthreads(); }
        { const int lane = tid & 63, wv = tid >> 6, g4 = lane >> 4, l16 = lane & 15; const bf16_t* H3B = (const bf16_t*)H3;
          bf16x8_t afr[2][2];
#pragma unroll
          for (int rt = 0; rt < 2; ++rt)
#pragma unroll
              for (int ks = 0; ks < 2; ++ks) afr[rt][ks] = *(const bf16x8_t*)(H3B + (16 * rt + l16) * 72 + 32 * ks + 8 * g4);
#pragma unroll 2
          for (int ctl = 0; ctl < 12; ++ctl) {
              const int cp = 16 * (wv * 12 + ctl) + l16;
              float wf[2][8];
#pragma unroll
              for (int ks = 0; ks < 2; ++ks)
#pragma unroll
                  for (int e = 0; e < 8; ++e) wf[ks][e] = w4[(32 * ks + 8 * g4 + e) * 1536 + cp];
              f32x4_t acc[2] = {{0.f, 0.f, 0.f, 0.f}, {0.f, 0.f, 0.f, 0.f}};
#pragma unroll
              for (int ks = 0; ks < 2; ++ks) { uint4 bw; bw.x = pk(wf[ks][0], wf[ks][1]); bw.y = pk(wf[ks][2], wf[ks][3]); bw.z = pk(wf[ks][4], wf[ks][5]); bw.w = pk(wf[ks][6], wf[ks][7]);
#pragma unroll
                  for (int rt = 0; rt < 2; ++rt) acc[rt] = __builtin_amdgcn_mfma_f32_16x16x32_bf16(afr[rt][ks], __builtin_bit_cast(bf16x8_t, bw), acc[rt], 0, 0, 0); }
              const bool bwd = cp >= DH; const int c = bwd ? cp - DH : cp;
              const float ad = fabsf(MIN_DECAY + (float)c * ((MAX_DECAY - MIN_DECAY) / 767.0f));
              float asum = 0.f; float* kc = KF + (size_t)c * NFFT + (bwd ? SEQ : 0);
#pragma unroll
              for (int rt = 0; rt < 2; ++rt) { float v[4];
#pragma unroll
                  for (int jj = 0; jj < 4; ++jj) { const int j = j0 + 16 * rt + 4 * g4 + jj; const float tj = (float)j * (1.0f / 8191.0f); v[jj] = acc[rt][jj] * __expf(-tj * ad); if (!bwd || j >= 1) asum += fabsf(v[jj]); }
                  *(float4*)(kc + j0 + 16 * rt + 4 * g4) = make_float4(v[0], v[1], v[2], v[3]); }
              asum += __shfl_xor(asum, 16); asum += __shfl_xor(asum, 32);
              if (g4 == 0) PS[item * 1536 + cp] = asum;
          } }
    }
}
__device__ void phase0(const Params& p, unsigned char* lds) {
    { float* rq = (float*)(p.ws + OFF_ROWSQ); for (int i = blockIdx.x * 512 + threadIdx.x; i < NTOK; i += gridDim.x * 512) rq[i] = 0.f; }
    const bool filter_first = (blockIdx.x & 1) != 0;
    if (filter_first) { phase_filter(p, lds); __syncthreads(); }
    phase_xn(p);
    transpose_to_bf16(p.in[2], DM, 4608, p.in[1], (bf16_t*)(p.ws + OFF_WT1), (float*)lds);
    transpose_to_bf16(p.in[25], 1536, DM, nullptr, (bf16_t*)(p.ws + OFF_WT2), (float*)lds);
    if (!filter_first) phase_filter(p, lds);
}
__device__ void phase_gemm1(const Params& p, unsigned char* lds) {
    PG8_LAS unsigned char* l3 = (PG8_LAS unsigned char*)lds;
    const bf16_t* XN = (const bf16_t*)(p.ws + OFF_XN); const bf16_t* WT1 = (const bf16_t*)(p.ws + OFF_WT1);
#pragma unroll 1
    for (int pass = 0; pass < 2; ++pass) {
        int ps = pass; asm volatile("" : "+s"(ps));
        pg8::StaticOrder S; pg8::Gemm g; pg8::EpiStoreBf16 E;
        g.A = ps ? XN : WT1; g.Bt = ps ? WT1 + (size_t)2304 * DM : XN; g.M = ps ? NTOK : 2304; g.N = ps ? 2304 : NTOK; g.K = DM;
        E.O = (bf16_t*)(p.ws + (ps ? OFF_P2 : OFF_HYT)); E.ldc = g.N;
        S.init(g.M, g.N, (int)gridDim.x, (int)blockIdx.x);
        pg8::gemm_phase<pg8::EpiStoreBf16, pg8::StaticOrder, false>(l3, g, S, E, nullptr);
        __syncthreads();
    }
}
__device__ void phase_gemm2(const Params& p, unsigned char* lds) {
    PG8_LAS unsigned char* l3 = (PG8_LAS unsigned char*)lds;
    pg8::Gemm g{(const bf16_t*)(p.ws + OFF_YCAT), (const bf16_t*)(p.ws + OFF_WT2), NTOK, DM, 1536};
    pg8::EpiFinal E{p.out, p.in[0], p.in[26], (float*)(p.ws + OFF_ROWSQ), (unsigned*)(p.ws + OFF_CNT)};
    const int G = (int)gridDim.x;
#pragma unroll 1
    for (int L = (int)blockIdx.x; L < 1024; L += G) {
        pg8::OneUnit S;
        if (G == 256) { const int r = L >> 8, c = L & 255, x = c & 7, t = c >> 3; S.pm = 64 * r + x * 8 + (t >> 2); S.pn = t & 3; }
        else { S.pm = L >> 2; S.pn = L & 3; }
        pg8::gemm_phase<pg8::EpiFinal, pg8::OneUnit, false>(l3, g, S, E, nullptr);
        __syncthreads();
    }
}
typedef float v2 __attribute__((ext_vector_type(2)));
__device__ __forceinline__ int phys(int e) { return e + ((e >> 5) << 1); }
__device__ __forceinline__ v2 cmulv(v2 a, v2 b) { v2 t, r;
    asm("v_pk_mul_f32 %0, %1, %2 op_sel:[0,0] op_sel_hi:[0,1]" : "=v"(t) : "v"(a), "v"(b));
    asm("v_pk_fma_f32 %0, %1, %2, %3 op_sel:[1,1,0] op_sel_hi:[1,0,1] neg_lo:[0,1,0]" : "=v"(r) : "v"(a), "v"(b), "v"(t));
    return r; }
template <int SGN> __device__ __forceinline__ void addsub_rot(v2 a, v2 b, v2& p, v2& m) {
    if (SGN < 0) { asm("v_pk_add_f32 %0, %1, %2 op_sel:[0,1] op_sel_hi:[1,0] neg_hi:[0,1]" : "=v"(p) : "v"(a), "v"(b));
                   asm("v_pk_add_f32 %0, %1, %2 op_sel:[0,1] op_sel_hi:[1,0] neg_lo:[0,1]" : "=v"(m) : "v"(a), "v"(b)); }
    else         { asm("v_pk_add_f32 %0, %1, %2 op_sel:[0,1] op_sel_hi:[1,0] neg_lo:[0,1]" : "=v"(p) : "v"(a), "v"(b));
                   asm("v_pk_add_f32 %0, %1, %2 op_sel:[0,1] op_sel_hi:[1,0] neg_hi:[0,1]" : "=v"(m) : "v"(a), "v"(b)); }
}
__device__ __forceinline__ constexpr float c16(int k) { return k == 0 ? 1.0f : k == 1 ? 0.9238795325112867f : k == 2 ? 0.7071067811865476f : k == 3 ? 0.3826834323650898f : k == 4 ? 0.0f : k == 6 ? -0.7071067811865476f : k == 9 ? -0.9238795325112867f : 0.0f; }
__device__ __forceinline__ constexpr float s16(int k) { return k == 0 ? 0.0f : k == 1 ? 0.3826834323650898f : k == 2 ? 0.7071067811865476f : k == 3 ? 0.9238795325112867f : k == 4 ? 1.0f : k == 6 ? 0.7071067811865476f : k == 9 ? -0.3826834323650898f : 0.0f; }
template <int SGN> __device__ __forceinline__ void bfly4(v2& a0, v2& a1, v2& a2, v2& a3) {
    const v2 t0 = a0 + a2, t1 = a0 - a2, t2 = a1 + a3, t3 = a1 - a3;
    a0 = t0 + t2; a2 = t0 - t2; addsub_rot<SGN>(t1, t3, a1, a3);
}
template <int SGN> __device__ __forceinline__ void dft16(v2 (&x)[16]) {
#pragma unroll
    for (int q2 = 0; q2 < 4; ++q2) bfly4<SGN>(x[q2], x[q2 + 4], x[q2 + 8], x[q2 + 12]);
#pragma unroll
    for (int q2 = 1; q2 < 4; ++q2)
#pragma unroll
        for (int r1 = 1; r1 < 4; ++r1) { const int k = q2 * r1; const v2 w = {c16(k), (float)SGN * s16(k)}; x[q2 + 4 * r1] = cmulv(x[q2 + 4 * r1], w); }
#pragma unroll
    for (int r1 = 0; r1 < 4; ++r1) bfly4<SGN>(x[4 * r1], x[4 * r1 + 1], x[4 * r1 + 2], x[4 * r1 + 3]);
}
#define FFT_TW_CHAIN() v2 tw[16]; { const float ang = (float)j * (1.0f / (float)M); const float sn = __builtin_amdgcn_sinf(ang), cs = __builtin_amdgcn_cosf(ang); \
          tw[0] = (v2){1.f, 0.f}; tw[1] = (v2){cs, (float)SGN * sn}; tw[2] = cmulv(tw[1], tw[1]); tw[3] = cmulv(tw[2], tw[1]); tw[4] = cmulv(tw[2], tw[2]); tw[5] = cmulv(tw[4], tw[1]); tw[6] = cmulv(tw[3], tw[3]); tw[7] = cmulv(tw[4], tw[3]); \
          tw[8] = cmulv(tw[4], tw[4]); tw[9] = cmulv(tw[8], tw[1]); tw[10] = cmulv(tw[5], tw[5]); tw[11] = cmulv(tw[8], tw[3]); tw[12] = cmulv(tw[6], tw[6]); tw[13] = cmulv(tw[8], tw[5]); tw[14] = cmulv(tw[7], tw[7]); tw[15] = cmulv(tw[8], tw[7]); }
template <int M, int SGN, int HALF> __device__ __forceinline__ void fft_pass16(v2* z, int tid) {
    constexpr int S = M / 16; constexpr int PS = (S >= 64) ? S + S / 16 : S;
#pragma unroll 1
    for (int it = 0; it < 2; ++it) {
        int t = tid + it * 512; asm volatile("" : "+v"(t)); const int j = t & (S - 1); const int base = (t / S) * M;
        v2* zp = z + phys(base + j);
        v2 x[16];
#pragma unroll
        for (int q = 0; q < 16; ++q) x[q] = (HALF && SGN < 0 && q >= 8) ? (v2){0.f, 0.f} : zp[q * PS];
        const float ang = (float)j * (1.0f / (float)M); const v2 w1 = {__builtin_amdgcn_cosf(ang), (float)SGN * __builtin_amdgcn_sinf(ang)};
        if (SGN > 0) { v2 w = w1;
#pragma unroll
            for (int q = 1; q < 16; ++q) { x[q] = cmulv(x[q], w); if (q < 15) w = cmulv(w, w1); }
            dft16<SGN>(x);
#pragma unroll
            for (int pp = 0; pp < 16; ++pp) { const int r = (pp >> 2) + 4 * (pp & 3); if (HALF && r >= 8) continue; zp[r * PS] = x[pp]; }
        } else {
            dft16<SGN>(x);
            v2 w = w1; zp[0] = x[0];
#pragma unroll
            for (int r = 1; r < 16; ++r) { const int pp = 4 * (r & 3) + (r >> 2); zp[r * PS] = cmulv(x[pp], w); if (r < 15) w = cmulv(w, w1); }
        }
    }
}
__device__ __forceinline__ constexpr float c32(int k) { return k == 0 ? 1.0f : k == 1 ? 0.9807852804032304f : k == 2 ? 0.9238795325112867f : k == 3 ? 0.8314696123025452f : k == 4 ? 0.7071067811865476f : k == 5 ? 0.5555702330196022f : k == 6 ? 0.3826834323650898f : k == 7 ? 0.1950903220161283f : k == 8 ? 0.0f
    : k == 9 ? -0.1950903220161283f : k == 10 ? -0.3826834323650898f : k == 11 ? -0.5555702330196022f : k == 12 ? -0.7071067811865476f : k == 13 ? -0.8314696123025452f : k == 14 ? -0.9238795325112867f : -0.9807852804032304f; }
__device__ __forceinline__ constexpr float s32(int k) { return k == 0 ? 0.0f : k == 1 ? 0.1950903220161283f : k == 2 ? 0.3826834323650898f : k == 3 ? 0.5555702330196022f : k == 4 ? 0.7071067811865476f : k == 5 ? 0.8314696123025452f : k == 6 ? 0.9238795325112867f : k == 7 ? 0.9807852804032304f : k == 8 ? 1.0f
    : k == 9 ? 0.9807852804032304f : k == 10 ? 0.9238795325112867f : k == 11 ? 0.8314696123025452f : k == 12 ? 0.7071067811865476f : k == 13 ? 0.5555702330196022f : k == 14 ? 0.3826834323650898f : 0.1950903220161283f; }
template <int SGN> __device__ __forceinline__ void dft32(v2 (&x)[32]) {
    v2 E[16], O[16];
#pragma unroll
    for (int i = 0; i < 16; ++i) { E[i] = x[2 * i]; O[i] = x[2 * i + 1]; }
    dft16<SGN>(E); dft16<SGN>(O);
#pragma unroll
    for (int k = 0; k < 16; ++k) { const int pp = 4 * (k & 3) + (k >> 2); v2 o = O[pp];
        if (k > 0) { const v2 w = {c32(k), (float)SGN * s32(k)}; o = cmulv(o, w); }
        x[k] = E[pp] + o; x[k + 16] = E[pp] - o; }
}
template <int SGN> __device__ __forceinline__ void fft_pass32(v2* z, int tid) {
    int t = tid; asm volatile("" : "+v"(t)); const int j = t & 31; v2* zp = z + phys((t >> 5) * 1024 + j);
    v2 x[32];
#pragma unroll
    for (int q = 0; q < 32; ++q) x[q] = zp[34 * q];
    const float ang = (float)j * (1.0f / 1024.0f); const v2 w1 = {__builtin_amdgcn_cosf(ang), (float)SGN * __builtin_amdgcn_sinf(ang)};
    if (SGN > 0) { v2 w = w1;
#pragma unroll
        for (int q = 1; q < 32; ++q) { x[q] = cmulv(x[q], w); if (q < 31) w = cmulv(w, w1); }
        dft32<SGN>(x);
#pragma unroll
        for (int q = 0; q < 32; ++q) zp[34 * q] = x[q];
    } else {
        dft32<SGN>(x);
        v2 w = w1; zp[0] = x[0];
#pragma unroll
        for (int r = 1; r < 32; ++r) { zp[34 * r] = cmulv(x[r], w); if (r < 31) w = cmulv(w, w1); }
    }
}
__device__ __forceinline__ void ld32(const v2* z, int tid, v2 (&x)[32]) { const float4* s = (const float4*)(z + phys(32 * tid));
#pragma unroll
    for (int i = 0; i < 16; ++i) { const float4 a = s[i]; x[2 * i] = (v2){a.x, a.y}; x[2 * i + 1] = (v2){a.z, a.w}; } }
__device__ __forceinline__ void st32(v2* z, int tid, const v2 (&x)[32]) { float4* s = (float4*)(z + phys(32 * tid));
#pragma unroll
    for (int i = 0; i < 16; ++i) s[i] = make_float4(x[2 * i].x, x[2 * i].y, x[2 * i + 1].x, x[2 * i + 1].y); }
struct In6 { uint2 w; unsigned halo; };
__device__ __forceinline__ In6 ld6(const bf16_t* seq, int l4) { In6 r; r.w = *(const uint2*)(seq + l4); const unsigned lo = l4 > 0 ? seq[l4 - 1] : 0u, hi = (l4 + 4 < SEQ) ? seq[l4 + 4] : 0u; r.halo = lo | (hi << 16); return r; }
__device__ __forceinline__ void conv3(const In6& in, float w0, float w1, float w2, float bb, float (&o)[4]) {
    const float i0 = bflo(in.halo), i1 = bflo(in.w.x), i2 = bfhi(in.w.x), i3 = bflo(in.w.y), i4 = bfhi(in.w.y), i5 = bfhi(in.halo);
    o[0] = bb + w0 * i0 + w1 * i1 + w2 * i2; o[1] = bb + w0 * i1 + w1 * i2 + w2 * i3; o[2] = bb + w0 * i2 + w1 * i3 + w2 * i4; o[3] = bb + w0 * i3 + w1 * i4 + w2 * i5;
}
__device__ void hyena_unit(const Params& p, unsigned char* lds, int c, int pr_lo, int pr_hi) {
    int tid = threadIdx.x; asm volatile("" : "+v"(tid)); const int lane = tid & 63, wid = tid >> 6;
    v2* z = (v2*)lds; float* red = (float*)(lds + ZPHYS * 8);
    const bf16_t* HYT = (const bf16_t*)(p.ws + OFF_HYT); bf16_t* YHT = (bf16_t*)(p.ws + OFF_YHT);
    const float* PS = (const float*)(p.ws + OFF_PS); const float* kf = (const float*)(p.ws + OFF_KF) + (size_t)c * NFFT;
    __syncthreads();
    { float part = 0.f; if (tid < 256) part = PS[tid * 1536 + c] + PS[tid * 1536 + DH + c];
      part = wave_sum(part); if (lane == 0 && wid < 4) red[wid] = part; }
    { float4 kv[8];
#pragma unroll
      for (int it = 0; it < 8; ++it) { const int e4 = (tid + 512 * it) * 4;
          if (it < 4) kv[it] = *(const float4*)(kf + e4);
          else { const float* q = kf + (3 * SEQ - e4); kv[it] = make_float4(e4 == SEQ ? 0.f : q[0], q[-1], q[-2], q[-3]); } }
      __syncthreads();
      const float scale = 1.0f / ((red[0] + red[1] + red[2] + red[3] + 1e-6f) * (float)NFFT);
#pragma unroll
      for (int it = 0; it < 8; ++it) { const int e4 = (tid + 512 * it) * 4; float4* d = (float4*)(z + phys(e4));
          d[0] = make_float4(kv[it].x * scale, 0.f, kv[it].y * scale, 0.f); d[1] = make_float4(kv[it].z * scale, 0.f, kv[it].w * scale, 0.f); } }
    __syncthreads();
    unsigned pw;
    { const int sq = tid >> 7; const bf16_t* sp = HYT + (size_t)((sq & 1) ? 2 * DH + c : c) * NTOK + (size_t)(2 * pr_lo + (sq >> 1)) * SEQ; pw = *(const unsigned*)((const char*)sp + (tid & 127) * 128); }
    fft_pass16<16384, -1, 0>(z, tid); __syncthreads(); fft_pass32<-1>(z, tid); __syncthreads();
    if (pw == 0x9e3779b9u) red[9] = 1.f;
    v2 kh[32];
    ld32(z, tid, kh); dft32<-1>(kh);
    const float* cw = p.in[3]; const float* cb = p.in[4];
    const float wv0 = cw[c], wv1 = cw[2304 + c], wv2 = cw[4608 + c], bv = cb[c];
    const float wa0 = cw[DH + c], wa1 = cw[2304 + DH + c], wa2 = cw[4608 + DH + c], ba = cb[DH + c];
    const float wb0 = cw[2 * DH + c], wb1 = cw[2304 + 2 * DH + c], wb2 = cw[4608 + 2 * DH + c], bbq = cb[2 * DH + c];
    const float dskip = p.in[15][c];
    const bf16_t* sv = HYT + (size_t)c * NTOK; const bf16_t* sx0 = HYT + (size_t)(DH + c) * NTOK; const bf16_t* sx1 = HYT + (size_t)(2 * DH + c) * NTOK;
#pragma unroll 1
    for (int pr = pr_lo; pr < pr_hi; ++pr) {
        const size_t o0 = (size_t)(2 * pr) * SEQ, o1 = o0 + SEQ;
        int tl = tid; asm volatile("" : "+v"(tl));
        unsigned uu[16];
        __syncthreads();
#pragma unroll
        for (int hh = 0; hh < 2; ++hh) { In6 a[2], b[2], cc[2], d[2];
#pragma unroll
          for (int i2 = 0; i2 < 2; ++i2) { const int it = 2 * hh + i2; const int l4 = (tl + 512 * it) * 4; a[i2] = ld6(sv + o0, l4); b[i2] = ld6(sx1 + o0, l4); cc[i2] = ld6(sv + o1, l4); d[i2] = ld6(sx1 + o1, l4); }
#pragma unroll
          for (int i2 = 0; i2 < 2; ++i2) { const int it = 2 * hh + i2; const int l4 = (tl + 512 * it) * 4; float v0[4], x10[4], v1[4], x11[4];
              conv3(a[i2], wv0, wv1, wv2, bv, v0); conv3(b[i2], wb0, wb1, wb2, bbq, x10); conv3(cc[i2], wv0, wv1, wv2, bv, v1); conv3(d[i2], wb0, wb1, wb2, bbq, x11);
#pragma unroll
              for (int s = 0; s < 4; ++s) { v0[s] *= x10[s]; v1[s] *= x11[s]; uu[4 * it + s] = pk(v0[s], v1[s]); }
              float4* dd = (float4*)(z + phys(l4));
              dd[0] = make_float4(v0[0], v1[0], v0[1], v1[1]); dd[1] = make_float4(v0[2], v1[2], v0[3], v1[3]); }
          __builtin_amdgcn_sched_barrier(0); }
        __syncthreads();
        fft_pass16<16384, -1, 1>(z, tid); __syncthreads(); fft_pass32<-1>(z, tid); __syncthreads();
        { v2 x[32]; ld32(z, tl, x); dft32<-1>(x);
#pragma unroll
          for (int r = 0; r < 32; ++r) x[r] = cmulv(x[r], kh[r]);
          dft32<1>(x); st32(z, tl, x); }
        __syncthreads();
        unsigned pf0, pf1;
        { const size_t on = (pr + 1 < pr_hi) ? o0 + 2 * SEQ : o0; const int sq = tid >> 7;
          const bf16_t* sp = ((sq & 1) ? sx1 : sv) + on + (sq >> 1) * SEQ; pf0 = *(const unsigned*)((const char*)sp + (tid & 127) * 128);
          const bf16_t* sp2 = sx0 + o0 + (sq & 1) * SEQ; pf1 = *(const unsigned*)((const char*)sp2 + (tid & 127) * 128); }
        fft_pass32<1>(z, tid); __syncthreads();
        fft_pass16<16384, 1, 1>(z, tid);
        In6 ea[4], eb[4];
#pragma unroll
        for (int it = 0; it < 4; ++it) { const int l4 = (tl + 512 * it) * 4; ea[it] = ld6(sx0 + o0, l4); eb[it] = ld6(sx0 + o1, l4); }
        __syncthreads();
#pragma unroll
        for (int it = 0; it < 4; ++it) { const int l4 = (tl + 512 * it) * 4; float x00[4], x01[4];
            conv3(ea[it], wa0, wa1, wa2, ba, x00); conv3(eb[it], wa0, wa1, wa2, ba, x01);
            const float4* s = (const float4*)(z + phys(l4)); const float4 a = s[0], b = s[1];
            const float cv0[4] = {a.x, a.z, b.x, b.z}, cv1[4] = {a.y, a.w, b.y, b.w};
            float y0[4], y1[4];
#pragma unroll
            for (int s4 = 0; s4 < 4; ++s4) { y0[s4] = x00[s4] * (cv0[s4] + dskip * bflo(uu[4 * it + s4])); y1[s4] = x01[s4] * (cv1[s4] + dskip * bfhi(uu[4 * it + s4])); }
            uint2 w0; w0.x = pk(y0[0], y0[1]); w0.y = pk(y0[2], y0[3]); uint2 w1; w1.x = pk(y1[0], y1[1]); w1.y = pk(y1[2], y1[3]);
            *(uint2*)(YHT + (size_t)c * NTOK + o0 + l4) = w0; *(uint2*)(YHT + (size_t)c * NTOK + o1 + l4) = w1; }
        if ((pf0 ^ pf1) == 0x9e3779b9u) red[8] = 1.f;
    }
}
__device__ void lru_unit(const Params& p, unsigned char* lds, int unit) {
    int tid = threadIdx.x; asm volatile("" : "+v"(tid)); const int lane = tid & 63, wid = __builtin_amdgcn_readfirstlane(tid >> 6);
    const int dir = unit / 96, rem = unit % 96, b = rem / 12, h = rem % 12;
    bf16_t* INs = (bf16_t*)lds + wid * (20 * 64);
    bf16_t* XB = (bf16_t*)(lds + 20480);
    float* AA = (float*)(lds + 38912);
    float* BB = (float*)(lds + 73728);
    float2* CAR = (float2*)(lds + 108544);
    float* HC = (float*)(lds + 116736);
    uint4* WB = (uint4*)(lds + 117248);
    float* CWL = (float*)(lds + 133632);
    const bf16_t* src = (const bf16_t*)(p.ws + OFF_P2) + (size_t)b * SEQ * 2304 + DH + h * 64;
    bf16_t* dst = (bf16_t*)(p.ws + (dir ? OFF_HB : OFF_HF)) + (size_t)b * SEQ * DH + h * 64;
    const float* wa = p.in[18] + (size_t)(dir * 12 + h) * 4096; const float* wx = p.in[20] + (size_t)(dir * 12 + h) * 4096;
    __syncthreads();
    for (int entry = tid; entry < 1024; entry += 512) { const int f = entry >> 6, ln = entry & 63, g = f >> 3, ct = (f >> 1) & 3, ks = f & 1; const int k0 = 32 * ks + 8 * (ln >> 4), col = 16 * ct + (ln & 15);
        const float* W = g ? wx : wa; float v[8];
#pragma unroll
        for (int e = 0; e < 8; ++e) v[e] = -1.4426950408889634f * W[(k0 + e) * 64 + col];
        uint4 w; w.x = pk(v[0], v[1]); w.y = pk(v[2], v[3]); w.z = pk(v[4], v[5]); w.w = pk(v[6], v[7]); WB[entry] = w; }
    if (tid < 128) HC[tid] = 0.f;
    if (tid < 320) { const int k = tid >> 6, ch = h * 64 + (tid & 63); CWL[tid] = (k < 4) ? p.in[16][k * DH + ch] : p.in[17][ch]; }
    const int oct = lane & 7, rl0 = lane >> 3;
    const int q = dir ? 7 - wid : wid;
    float gba[4], gbx[4], sp8[4];
#pragma unroll
    for (int ct = 0; ct < 4; ++ct) { const int ch = dir * DH + h * 64 + 16 * ct + (lane & 15); gba[ct] = -1.4426950408889634f * p.in[19][ch]; gbx[ct] = -1.4426950408889634f * p.in[21][ch];
        const float e = __expf(-p.in[22][ch]); const float sp = (e < 0.02f) ? e * (1.0f - e * (0.5f - e * (1.0f / 3.0f))) : __logf(1.0f + e); sp8[ct] = 8.0f * 1.4426950408889634f * sp; }
    uint4 R[3];
#define LRU_ISSUE(l0v) { _Pragma("unroll") for (int i = 0; i < 3; ++i) { const int item = lane + 64 * i, r = item >> 3, o = item & 7, l = (l0v) - 1 + 16 * wid + r; const bool ok = (item < 152) && l >= 0 && l < SEQ; \
        R[i] = ok ? *(const uint4*)(src + (size_t)l * 2304 + o * 8) : make_uint4(0u, 0u, 0u, 0u); } }
    LRU_ISSUE(dir ? SEQ - 128 : 0)
    __syncthreads();
    float cwr[5][8];
#pragma unroll
    for (int k = 0; k < 5; ++k) { const float4 c0 = *(const float4*)(CWL + k * 64 + oct * 8), c1 = *(const float4*)(CWL + k * 64 + oct * 8 + 4);
        cwr[k][0] = c0.x; cwr[k][1] = c0.y; cwr[k][2] = c0.z; cwr[k][3] = c0.w; cwr[k][4] = c1.x; cwr[k][5] = c1.y; cwr[k][6] = c1.z; cwr[k][7] = c1.w; }
#pragma unroll 1
    for (int T = 0; T < 64; ++T) {
        const int l0 = dir ? SEQ - 128 * (T + 1) : 128 * T;
#pragma unroll
        for (int i = 0; i < 3; ++i) { const int item = lane + 64 * i; if (item < 160) *(uint4*)(INs + (item >> 3) * 64 + (item & 7) * 8) = R[i]; }
        asm volatile("" ::: "memory");
        if (T + 1 < 64) LRU_ISSUE(dir ? SEQ - 128 * (T + 2) : 128 * (T + 1))
#pragma unroll
        for (int i = 0; i < 2; ++i) { const int rl = rl0 + 8 * i; float acc[8];
#pragma unroll
            for (int e = 0; e < 8; ++e) acc[e] = cwr[4][e];
#pragma unroll
            for (int k = 0; k < 4; ++k) { const uint4 w = *(const uint4*)(INs + (rl + k) * 64 + oct * 8);
                acc[0] += cwr[k][0] * bflo(w.x); acc[1] += cwr[k][1] * bfhi(w.x); acc[2] += cwr[k][2] * bflo(w.y); acc[3] += cwr[k][3] * bfhi(w.y);
                acc[4] += cwr[k][4] * bflo(w.z); acc[5] += cwr[k][5] * bfhi(w.z); acc[6] += cwr[k][6] * bflo(w.w); acc[7] += cwr[k][7] * bfhi(w.w); }
            uint4 o; o.x = pk(acc[0], acc[1]); o.y = pk(acc[2], acc[3]); o.z = pk(acc[4], acc[5]); o.w = pk(acc[6], acc[7]);
            *(uint4*)(XB + (16 * wid + rl) * 72 + oct * 8) = o; }
        asm volatile("" ::: "memory");
        { const int rowA = 16 * wid + (lane & 15);
          const bf16x8_t a0 = *(const bf16x8_t*)(XB + rowA * 72 + 8 * (lane >> 4)), a1 = *(const bf16x8_t*)(XB + rowA * 72 + 32 + 8 * (lane >> 4));
          const int firstrow = dir ? 127 : 0;
#pragma unroll
          for (int ct = 0; ct < 4; ++ct) {
              f32x4_t accA = {gba[ct], gba[ct], gba[ct], gba[ct]}, accX = {gbx[ct], gbx[ct], gbx[ct], gbx[ct]};
              const uint4 b0 = WB[((0 * 4 + ct) * 2 + 0) * 64 + lane], b1 = WB[((0 * 4 + ct) * 2 + 1) * 64 + lane], b2 = WB[((1 * 4 + ct) * 2 + 0) * 64 + lane], b3 = WB[((1 * 4 + ct) * 2 + 1) * 64 + lane];
              accA = __builtin_amdgcn_mfma_f32_16x16x32_bf16(a0, __builtin_bit_cast(bf16x8_t, b0), accA, 0, 0, 0);
              accA = __builtin_amdgcn_mfma_f32_16x16x32_bf16(a1, __builtin_bit_cast(bf16x8_t, b1), accA, 0, 0, 0);
              accX = __builtin_amdgcn_mfma_f32_16x16x32_bf16(a0, __builtin_bit_cast(bf16x8_t, b2), accX, 0, 0, 0);
              accX = __builtin_amdgcn_mfma_f32_16x16x32_bf16(a1, __builtin_bit_cast(bf16x8_t, b3), accX, 0, 0, 0);
              const int ch = 16 * ct + (lane & 15);
#pragma unroll
              for (int j = 0; j < 4; ++j) { const int row = 16 * wid + 4 * (lane >> 4) + j;
                  const float r = __builtin_amdgcn_rcpf(1.0f + __builtin_amdgcn_exp2f(accA[j])), ig = __builtin_amdgcn_rcpf(1.0f + __builtin_amdgcn_exp2f(accX[j]));
                  const float a = __builtin_amdgcn_exp2f(-sp8[ct] * r); float mult = __builtin_amdgcn_sqrtf(fmaxf(1.0f - a * a, 0.f));
                  if (T == 0 && row == firstrow) mult = 1.0f;
                  const float xbv = bf2f(XB[row * 72 + ch]);
                  AA[row * 68 + ch] = a; BB[row * 68 + ch] = mult * ig * xbv; } } }
        asm volatile("" ::: "memory");
        { float av[16], bv[16]; float P = 1.f, H = 0.f;
#pragma unroll
          for (int s = 0; s < 16; ++s) { const int row = 16 * wid + (dir ? 15 - s : s); av[s] = AA[row * 68 + lane]; bv[s] = BB[row * 68 + lane]; H = av[s] * H + bv[s]; P *= av[s]; }
          CAR[((T & 1) * 8 + q) * 64 + lane] = make_float2(P, H);
          __syncthreads();
          float hin = HC[(T & 1) * 64 + lane];
          for (int s2 = 0; s2 < q; ++s2) { const float2 c2 = CAR[((T & 1) * 8 + s2) * 64 + lane]; hin = c2.x * hin + c2.y; }
#pragma unroll
          for (int s = 0; s < 16; ++s) { const int row = 16 * wid + (dir ? 15 - s : s); hin = av[s] * hin + bv[s]; dst[(size_t)(l0 + row) * DH + lane] = (bf16_t)(pk(hin, hin) & 0xffffu); }
          if (q == 7) HC[((T + 1) & 1) * 64 + lane] = hin; }
    }
#undef LRU_ISSUE
}
__device__ void phase_mix(const Params& p, unsigned char* lds, int which, int skip = 0) {
    unsigned* ctr = (unsigned*)(p.ws + OFF_CTL) + which; volatile int* slot = (volatile int*)(lds + LDS_BYTES - 16);
    for (;;) {
        __syncthreads();
        if (threadIdx.x == 0) *slot = (int)atomicAdd(ctr, 1u);
        __syncthreads();
        const int u = __builtin_amdgcn_readfirstlane(*slot);
        if (u >= N_LRU_UNITS + N_HY_FULL + 2 * (N_HY_UNITS - N_HY_FULL)) break;
        if (u < N_LRU_UNITS) { if (skip != 1) lru_unit(p, lds, u); }
        else if (skip != 2) { const int v = u - N_LRU_UNITS;
            if (v < N_HY_FULL) hyena_unit(p, lds, v, 0, 4);
            else { const int w = v - N_HY_FULL; hyena_unit(p, lds, N_HY_FULL + (w >> 1), (w & 1) * 2, (w & 1) * 2 + 2); } }
    }
}
__device__ void phase_ycat(const Params& p, unsigned char* lds) {
    const int tid = threadIdx.x, lane = tid & 63, wid = tid >> 6;
    unsigned* T = (unsigned*)lds; const unsigned short* Th = (const unsigned short*)lds;
    const bf16_t* YHT = (const bf16_t*)(p.ws + OFF_YHT); const bf16_t* P2 = (const bf16_t*)(p.ws + OFF_P2);
    const bf16_t* HF = (const bf16_t*)(p.ws + OFF_HF); const bf16_t* HB = (const bf16_t*)(p.ws + OFF_HB); bf16_t* YC = (bf16_t*)(p.ws + OFF_YCAT);
    float hg[12], lg[12];
#pragma unroll
    for (int m = 0; m < 6; ++m) { hg[2 * m] = p.in[23][2 * lane + 128 * m]; hg[2 * m + 1] = p.in[23][2 * lane + 128 * m + 1]; }
#pragma unroll
    for (int m = 0; m < 3; ++m)
#pragma unroll
        for (int e = 0; e < 4; ++e) lg[4 * m + e] = p.in[24][4 * lane + 256 * m + e];
    uint4 yt[12];
    { const int tok0 = blockIdx.x * 64;
#pragma unroll
      for (int i = 0; i < 12; ++i) { const int idx = tid + 512 * i, c = idx >> 3, seg = idx & 7; yt[i] = (blockIdx.x < NTOK / 64) ? *(const uint4*)(YHT + (size_t)c * NTOK + tok0 + seg * 8) : make_uint4(0u, 0u, 0u, 0u); } }
    for (int tile = blockIdx.x; tile < NTOK / 64; tile += gridDim.x) {
        const int tok0 = tile * 64;
        __syncthreads();
#pragma unroll
        for (int i = 0; i < 12; ++i) { const int idx = tid + 512 * i, c = idx >> 3, seg = idx & 7; unsigned* d = T + c * 33 + seg * 4; d[0] = yt[i].x; d[1] = yt[i].y; d[2] = yt[i].z; d[3] = yt[i].w; }
        __syncthreads();
        { const int ntile = tile + gridDim.x; const int tokn = (ntile < NTOK / 64 ? ntile : tile) * 64;
#pragma unroll
          for (int i = 0; i < 12; ++i) { const int idx = tid + 512 * i, c = idx >> 3, seg = idx & 7; yt[i] = *(const uint4*)(YHT + (size_t)c * NTOK + tokn + seg * 8); } }
        unsigned gh[2][6]; uint2 hf[2][3], hb[2][3], gl[2][3];
#define YC_ISSUE(slot, ii) { const size_t tk = (size_t)tok0 + 8 * wid + (ii); \
            _Pragma("unroll") for (int m = 0; m < 6; ++m) gh[slot][m] = *(const unsigned*)(P2 + tk * 2304 + 2 * lane + 128 * m); \
            _Pragma("unroll") for (int m = 0; m < 3; ++m) { const int c = 4 * lane + 256 * m; hf[slot][m] = *(const uint2*)(HF + tk * DH + c); hb[slot][m] = *(const uint2*)(HB + tk * DH + c); gl[slot][m] = *(const uint2*)(P2 + tk * 2304 + 1536 + c); } }
        YC_ISSUE(0, 0)
#pragma unroll
        for (int i = 0; i < 8; ++i) { const int t = 8 * wid + i; const size_t tok = (size_t)tok0 + t; const int cs = i & 1, ns = cs ^ 1;
            if (i < 7) YC_ISSUE(ns, i + 1)
            float y[12]; float ss = 0.f;
#pragma unroll
            for (int m = 0; m < 6; ++m) { const int c = 2 * lane + 128 * m; y[2 * m] = bf2f(Th[c * 66 + t]); y[2 * m + 1] = bf2f(Th[(c + 1) * 66 + t]); ss += y[2 * m] * y[2 * m] + y[2 * m + 1] * y[2 * m + 1]; }
            ss = wave_sum(ss); const float rs = rsqrtf(ss * (1.0f / DH) + 1e-6f);
#pragma unroll
            for (int m = 0; m < 6; ++m) { const int c = 2 * lane + 128 * m; const unsigned gw = gh[cs][m]; const float g0 = bflo(gw), g1 = bfhi(gw);
                const float o0 = y[2 * m] * rs * hg[2 * m] * (g0 * sigm(g0)), o1 = y[2 * m + 1] * rs * hg[2 * m + 1] * (g1 * sigm(g1));
                *(unsigned*)(YC + tok * 1536 + c) = pk(o0, o1); }
            float q[12]; float s2 = 0.f;
#pragma unroll
            for (int m = 0; m < 3; ++m) { const uint2 f = hf[cs][m], bq = hb[cs][m];
                q[4 * m] = bflo(f.x) + bflo(bq.x); q[4 * m + 1] = bfhi(f.x) + bfhi(bq.x); q[4 * m + 2] = bflo(f.y) + bflo(bq.y); q[4 * m + 3] = bfhi(f.y) + bfhi(bq.y);
                s2 += q[4 * m] * q[4 * m] + q[4 * m + 1] * q[4 * m + 1] + q[4 * m + 2] * q[4 * m + 2] + q[4 * m + 3] * q[4 * m + 3]; }
            s2 = wave_sum(s2); const float rs2 = rsqrtf(s2 * (1.0f / DH) + 1e-6f);
#pragma unroll
            for (int m = 0; m < 3; ++m) { const int c = 4 * lane + 256 * m; const uint2 gw = gl[cs][m];
                const float g0 = bflo(gw.x), g1 = bfhi(gw.x), g2 = bflo(gw.y), g3 = bfhi(gw.y);
                uint2 o; o.x = pk(q[4 * m] * rs2 * lg[4 * m] * (g0 * sigm(g0)), q[4 * m + 1] * rs2 * lg[4 * m + 1] * (g1 * sigm(g1)));
                o.y = pk(q[4 * m + 2] * rs2 * lg[4 * m + 2] * (g2 * sigm(g2)), q[4 * m + 3] * rs2 * lg[4 * m + 3] * (g3 * sigm(g3)));
                *(uint2*)(YC + tok * 1536 + DH + c) = o; }
        }
#undef YC_ISSUE
    }
}
__device__ void phase_final(const Params& p) {
    const int tid = threadIdx.x, lane = tid & 63, wid = tid >> 6;
    const float4* g4 = (const float4*)p.in[26]; float4 gv[4];
#pragma unroll
    for (int i = 0; i < 4; ++i) gv[i] = g4[i * 64 + lane];
    for (int row = blockIdx.x * 8 + wid; row < NTOK; row += gridDim.x * 8) {
        float4* src = (float4*)(p.out + (size_t)row * DM);
        float4 v[4]; float ss = 0.f;
#pragma unroll
        for (int i = 0; i < 4; ++i) { v[i] = src[i * 64 + lane]; ss += v[i].x * v[i].x + v[i].y * v[i].y + v[i].z * v[i].z + v[i].w * v[i].w; }
        ss = wave_sum(ss);
        const float rs = rsqrtf(ss * (1.0f / DM) + 1e-6f);
#pragma unroll
        for (int i = 0; i < 4; ++i) src[i * 64 + lane] = make_float4(v[i].x * rs * gv[i].x, v[i].y * rs * gv[i].y, v[i].z * rs * gv[i].z, v[i].w * rs * gv[i].w);
    }
}

#define XB_TMO      128
#define XB_XCNT(j)  (256  + 64 * (j))
#define XB_XSUB(j)  (1280 + 64 * (j))
#define XB_XGEN(j)  (2304 + 64 * (j))
#define XB_TOP      3328
#define XB_TOPGEN   3392
#define XCD_BAR_WORDS 3456
#define XB_SPIN_CAP (1u << 18)
#define LAS __attribute__((address_space(3)))

__device__ __forceinline__ unsigned xb_ld(unsigned* p)              { return __hip_atomic_load(p, __ATOMIC_RELAXED, __HIP_MEMORY_SCOPE_AGENT); }
__device__ __forceinline__ unsigned xb_add(unsigned* p, unsigned v) { return __hip_atomic_fetch_add(p, v, __ATOMIC_RELAXED, __HIP_MEMORY_SCOPE_AGENT); }
__device__ __forceinline__ unsigned xb_xcc_id() { return (unsigned)__builtin_amdgcn_s_getreg((3 << 11) | 20) & 0xFu; }
#define XB_SPIN(cond, bar) do { unsigned _sp = 0; while (cond) { __builtin_amdgcn_s_sleep(1); \
    if ((++_sp & 255u) == 0u) { if (xb_ld(&(bar)[XB_TMO])) break; if (_sp > XB_SPIN_CAP) { atomicAdd(&(bar)[XB_TMO], 1u); break; } } } } while (0)

struct XcdBarrier {
    unsigned* bar; unsigned x;
    volatile LAS unsigned* st;
};

__device__ __forceinline__ XcdBarrier xcd_barrier_post(unsigned* bar, volatile LAS unsigned* st) {
    XcdBarrier b; b.bar = bar; b.x = xb_xcc_id(); b.st = st;
    if (threadIdx.x == 0) (void)xb_add(&bar[XB_XCNT(b.x)], 1u);
    return b;
}
__device__ __forceinline__ void xcd_barrier_complete(unsigned* bar, unsigned x, unsigned& nloc, unsigned& nx) {
    const unsigned G = gridDim.x * gridDim.y * gridDim.z;
    unsigned sum, cnt, mine, sp = 0u;
    for (;;) {
        sum = 0u; cnt = 0u; mine = 0u;
#pragma unroll
        for (unsigned j = 0; j < 16; ++j) { const unsigned c = xb_ld(&bar[XB_XCNT(j)]); sum += c; cnt += (c > 0u) ? 1u : 0u; mine = (j == x) ? c : mine; }
        if (sum == G) break;
        __builtin_amdgcn_s_sleep(1);
        if ((++sp & 255u) == 0u) { if (xb_ld(&bar[XB_TMO])) break; if (sp > XB_SPIN_CAP) { atomicAdd(&bar[XB_TMO], 1u); break; } }
    }
    nloc = mine > 0u ? mine : 1u; nx = cnt > 0u ? cnt : 1u;
}

__device__ __forceinline__ void xcd_barrier(const XcdBarrier& b) {
    asm volatile("s_waitcnt vmcnt(0)" ::: "memory");
    __syncthreads();
    if (threadIdx.x == 0) {
        unsigned* bar = b.bar;
        __builtin_amdgcn_s_waitcnt(0);
        unsigned nloc = b.st[0], nx = b.st[1];
        if (nloc == 0u) { xcd_barrier_complete(bar, b.x, nloc, nx); b.st[0] = nloc; b.st[1] = nx; }
        const unsigned old = xb_add(&bar[XB_XSUB(b.x)], 1u);
        const unsigned gen = old / nloc;
        if (old + 1u == (gen + 1u) * nloc) {
            __builtin_amdgcn_fence(__ATOMIC_RELEASE, "agent");
            asm volatile("s_waitcnt vmcnt(0)" ::: "memory");
            const unsigned og = xb_add(&bar[XB_TOP], 1u);
            const unsigned tg = og / nx;
            if (og + 1u == (tg + 1u) * nx) xb_add(&bar[XB_TOPGEN], 1u);
            else XB_SPIN(xb_ld(&bar[XB_TOPGEN]) == tg, bar);
            __builtin_amdgcn_fence(__ATOMIC_ACQUIRE, "agent");
            xb_add(&bar[XB_XGEN(b.x)], 1u);
            asm volatile("s_waitcnt vmcnt(0)" ::: "memory");
        } else {
            XB_SPIN(xb_ld(&bar[XB_XGEN(b.x)]) == gen, bar);
            __builtin_amdgcn_fence(__ATOMIC_ACQUIRE, "agent");
            asm volatile("s_waitcnt vmcnt(0)" ::: "memory");
        }
    }
    __syncthreads();
}

constexpr int N_PHASES = 5;
__global__ void __launch_bounds__(512) hymba_fwd(Params p) {
    extern __shared__ __attribute__((aligned(16))) unsigned char lds[];
    cg::grid_group grid = cg::this_grid();
#ifndef ONLY_PHASE
#define ONLY_PHASE -1
#endif
#define PH_ON(n) (ONLY_PHASE < 0 || ONLY_PHASE == (n))
#ifndef DUP_SKIP
#define DUP_SKIP 0
#endif
#ifndef DUP_PHASE
#define DUP_PHASE -1
#endif
    const int lo = p.ph_lo, hi = p.ph_hi;
    volatile LAS unsigned* xst = (volatile LAS unsigned*)((LAS unsigned char*)lds + (LDS_BYTES - 32));
    if (threadIdx.x == 0) { xst[0] = 0u; xst[1] = 0u; }
    __syncthreads();
    const XcdBarrier xb = xcd_barrier_post((unsigned*)(p.ws + OFF_XBAR), xst);
    if (hi > 1000) grid.sync();
    if (lo <= 0 && 0 < hi) { if (PH_ON(0)) phase0(p, lds); if (DUP_PHASE == 0) { grid.sync(); phase0(p, lds); } }
    if (lo <= 1 && 1 < hi) { if (lo < 1) xcd_barrier(xb); if (PH_ON(1)) phase_gemm1(p, lds); if (DUP_PHASE == 1) { grid.sync(); phase_gemm1(p, lds); } }
    if (lo <= 2 && 2 < hi) { if (lo < 2) xcd_barrier(xb); if (PH_ON(2)) phase_mix(p, lds, 0, MIX_SEL); if (DUP_PHASE == 2) { grid.sync(); phase_mix(p, lds, 1, DUP_SKIP); } }
    if (lo <= 3 && 3 < hi) { if (lo < 3) xcd_barrier(xb); if (PH_ON(3)) phase_ycat(p, lds); if (DUP_PHASE == 3) { grid.sync(); phase_ycat(p, lds); } }
    if (lo <= 4 && 4 < hi) { if (lo < 4) xcd_barrier(xb); if (PH_ON(4)) phase_gemm2(p, lds); if (DUP_PHASE == 4) { grid.sync(); phase_gemm2(p, lds); } }
}
extern "C" void kernel_launch(void* const* d_in, const int* in_sizes, int n_in, void* d_out, int out_size, void* d_ws, size_t ws_size, hipStream_t stream) {
    static int grid = 0;
    if (grid == 0) {
        if (n_in != 27 || ws_size < WS_END) { fprintf(stderr, "kernel_launch: expected 27 inputs and >= %zu bytes of workspace (got %d, %zu)\n", (size_t)WS_END, n_in, ws_size); grid = -1; return; }
        int dev = 0, cus = 0, per_cu = 0;
        hipGetDevice(&dev); hipDeviceGetAttribute(&cus, hipDeviceAttributeMultiprocessorCount, dev);
        if (hipFuncSetAttribute((const void*)hymba_fwd, hipFuncAttributeMaxDynamicSharedMemorySize, LDS_BYTES) != hipSuccess) { fprintf(stderr, "kernel_launch: hipFuncSetAttribute failed\n"); grid = -1; return; }
        if (hipOccupancyMaxActiveBlocksPerMultiprocessor(&per_cu, (const void*)hymba_fwd, 512, LDS_BYTES) != hipSuccess || per_cu < 1) { fprintf(stderr, "kernel_launch: occupancy query failed (%d)\n", per_cu); (void)hipGetLastError(); grid = -1; return; }
        grid = cus * per_cu; if (grid > 256) grid = 256; grid &= ~3;
    }
    if (grid < 0) return;
    hipMemsetAsync((char*)d_ws + OFF_CTL, 0, 32768, stream);
    Params p{};
    for (int i = 0; i < 27; ++i) p.in[i] = (const float*)d_in[i];
    p.out = (float*)d_out; p.ws = (unsigned char*)d_ws;
    const int per = (N_PHASES + MK_N_LAUNCHES - 1) / MK_N_LAUNCHES;
    for (int lo = 0; lo < N_PHASES; lo += per) {
        p.ph_lo = lo; p.ph_hi = lo + per < N_PHASES ? lo + per : N_PHASES;
        void* args[] = {&p};
        const hipError_t e = hipLaunchCooperativeKernel((const void*)hymba_fwd, dim3(grid), dim3(512), args, LDS_BYTES, stream);
        if (e != hipSuccess) { fprintf(stderr, "kernel_launch: cooperative launch failed: %s (grid %d)\n", hipGetErrorString(e), grid); break; }
    }
}
```

```cpp
#include <hip/hip_runtime.h>
#include <hip/hip_cooperative_groups.h>
#include <cstdio>
namespace cg = cooperative_groups;
#ifndef MK_N_LAUNCHES
#define MK_N_LAUNCHES 1
#endif
namespace pg8 {
#define PG8_LAS __attribute__((address_space(3)))
typedef unsigned short bf16_t;
typedef short bf16x8 __attribute__((ext_vector_type(8)));
typedef float f32x4 __attribute__((ext_vector_type(4)));
typedef unsigned u32x4 __attribute__((ext_vector_type(4)));
constexpr int BM = 256, BK = 64, HALF = 128, HTB = HALF * BK * 2  , STAGE_BYTES = 8 * HTB, NXCD = 8, WGM = 8;

__host__ __device__ __forceinline__ int lds_byte(int r, int c) { const int st = (r >> 4) * 2 + (c >> 5), rr = r & 15, cc = c & 31, ob = rr * 64 + cc * 2; return st * 1024 + (ob ^ (((ob >> 9) & 1) << 5)); }
__host__ __device__ __forceinline__ void stage_rc(int b, int& R, int& C) { const int st = b / 1024, sb = b % 1024, swz = sb ^ (((sb >> 9) & 1) << 5); R = (st >> 1) * 16 + swz / 64; C = (st & 1) * 32 + (swz % 64) / 2; }
__host__ __device__ __forceinline__ int perm32(int rho) { const int n = rho >> 4, i = rho & 15; return 8 * (i >> 2) + 4 * n + (i & 3); }

struct Unit { int pm, pn; };
struct Gemm { const bf16_t* A; const bf16_t* Bt; int M, N, K; };

struct StaticOrder {
    int nM, nN, nwg, G, c;
    __host__ __device__ void init(int M, int N, int G_, int c_) { nM = M / BM; nN = N / BM; nwg = nM * nN; G = G_; c = c_; }
    __host__ __device__ bool next(int i, Unit& u) const {
        const long L = (long)i * G + c; if (L >= nwg) return false;
        int wgid = (int)L; { const int q = nwg / NXCD, r = nwg % NXCD, xcd = wgid % NXCD, off = wgid / NXCD; wgid = (xcd < r ? xcd * (q + 1) : r * (q + 1) + (xcd - r) * q) + off; }
        const int nig = WGM * nN, gid = wgid / nig, fm = gid * WGM, gsz = (nM - fm) < WGM ? (nM - fm) : WGM;
        u.pm = fm + ((wgid % nig) % gsz); u.pn = (wgid % nig) / gsz; return true;
    }
    __device__ __forceinline__ void a_ready(const Unit&) const {}
    __device__ __forceinline__ void done(const Unit&) const {}
};
__device__ __forceinline__ unsigned cvt_pk_bf16(float lo, float hi) { unsigned r; asm volatile("v_cvt_pk_bf16_f32 %0, %1, %2" : "=v"(r) : "v"(lo), "v"(hi)); return r; }
typedef float f32x2 __attribute__((ext_vector_type(2)));

struct EpiStoreBf16 {
    static constexpr bool PERM = true, AFTER_DRAIN = false;
    bf16_t* O; int ldc;
    __device__ __forceinline__ void operator()(const f32x4 (&acc)[2][2][4][2], const Unit& u, int wr, int wc, int fr, int fq) const {
        const int row0 = u.pm * BM + wr * 64 + fr; const int col0 = u.pn * BM + wc * 32 + 8 * fq;
#pragma unroll
        for (int ai = 0; ai < 2; ++ai)
#pragma unroll
            for (int m = 0; m < 4; ++m) { bf16_t* rowp = O + (size_t)(row0 + ai * HALF + m * 16) * ldc + col0;
#pragma unroll
                for (int bj = 0; bj < 2; ++bj) { const f32x4 v0 = acc[ai][bj][m][0], v1 = acc[ai][bj][m][1];
                    u32x4 w; w.x = cvt_pk_bf16(v0[0], v0[1]); w.y = cvt_pk_bf16(v0[2], v0[3]); w.z = cvt_pk_bf16(v1[0], v1[1]); w.w = cvt_pk_bf16(v1[2], v1[3]);
                    *(u32x4*)(rowp + bj * HALF) = w; } }
    }
};
struct EpiResidF32 {
    static constexpr bool PERM = false, AFTER_DRAIN = false;
    float* C; const float* X; int ldc;
    __device__ __forceinline__ void operator()(const f32x4 (&acc)[2][2][4][2], const Unit& u, int wr, int wc, int fr, int fq) const {
        const int row0 = u.pm * BM + wr * 64 + fr, col0 = u.pn * BM + wc * 32 + 4 * fq;
#pragma unroll
        for (int ai = 0; ai < 2; ++ai)
#pragma unroll
            for (int m = 0; m < 4; ++m) { const size_t off = (size_t)(row0 + ai * HALF + m * 16) * ldc + col0;
#pragma unroll
                for (int bj = 0; bj < 2; ++bj)
#pragma unroll
                    for (int n = 0; n < 2; ++n) { const f32x4 xv = *(const f32x4*)(X + off + bj * HALF + n * 16); *(f32x4*)(C + off + bj * HALF + n * 16) = acc[ai][bj][m][n] + xv; } }
    }
};
struct OneUnit {
    int pm, pn;
    __device__ __forceinline__ bool next(int i, Unit& u) const { if (i) return false; u.pm = pm; u.pn = pn; return true; }
    __device__ __forceinline__ void a_ready(const Unit&) const {}
    __device__ __forceinline__ void done(const Unit&) const {}
};
struct EpiFinal {
    static constexpr bool PERM = false, AFTER_DRAIN = true;
    float* C; const float* X; const float* G; float* rowsq; unsigned* cnt;
    __device__ __forceinline__ void fused(f32x4 (&acc)[2][2][4][2], const Unit& u, int wr, int wc, int fr, int fq, PG8_LAS unsigned char* lds, int wid, int lane) const {
        PG8_LAS float* P = (PG8_LAS float*)lds;
        PG8_LAS float* S = (PG8_LAS float*)(lds + 4096);
        const int tid = wid * 64 + lane;
        const int row0 = u.pm * BM + wr * 64 + fr, col0 = u.pn * BM + wc * 32 + 4 * fq;
#pragma unroll
        for (int ai = 0; ai < 2; ++ai)
#pragma unroll
            for (int m = 0; m < 4; ++m) { const size_t off = (size_t)(row0 + ai * HALF + m * 16) * 1024 + col0; float s = 0.f;
#pragma unroll
                for (int bj = 0; bj < 2; ++bj)
#pragma unroll
                    for (int n = 0; n < 2; ++n) { const f32x4 xv = *(const f32x4*)(X + off + bj * HALF + n * 16); const f32x4 v = acc[ai][bj][m][n] + xv; acc[ai][bj][m][n] = v;
                        s += (v[0] * v[0] + v[1] * v[1]) + (v[2] * v[2] + v[3] * v[3]); }
                s += __shfl_xor(s, 16); s += __shfl_xor(s, 32);
                if (fq == 0) P[(ai * HALF + wr * 64 + m * 16 + fr) * 4 + wc] = s; }
        __syncthreads();
        { float back = 0.f;
          if (tid < 256) { const float tot = (P[tid * 4] + P[tid * 4 + 1]) + (P[tid * 4 + 2] + P[tid * 4 + 3]);
              back = __hip_atomic_fetch_add(rowsq + u.pm * BM + tid, tot, __ATOMIC_RELAXED, __HIP_MEMORY_SCOPE_AGENT); }
          asm volatile("s_waitcnt vmcnt(0)" :: "v"(back) : "memory"); }
        __syncthreads();
        if (tid == 0) {
            __hip_atomic_fetch_add(cnt + u.pm, 1u, __ATOMIC_RELAXED, __HIP_MEMORY_SCOPE_AGENT);
            unsigned sp = 0;
            while (__hip_atomic_load(cnt + u.pm, __ATOMIC_RELAXED, __HIP_MEMORY_SCOPE_AGENT) < 4u) { __builtin_amdgcn_s_sleep(1); if (++sp > (1u << 22)) break; }
        }
        __syncthreads();
        if (tid < 256) S[tid] = __builtin_amdgcn_rsqf(__hip_atomic_load(rowsq + u.pm * BM + tid, __ATOMIC_RELAXED, __HIP_MEMORY_SCOPE_AGENT) * (1.0f / 1024.0f) + 1e-6f);
        __syncthreads();
        f32x4 gv[2][2];
#pragma unroll
        for (int bj = 0; bj < 2; ++bj)
#pragma unroll
            for (int n = 0; n < 2; ++n) gv[bj][n] = *(const f32x4*)(G + col0 + bj * HALF + n * 16);
#pragma unroll
        for (int ai = 0; ai < 2; ++ai)
#pragma unroll
            for (int m = 0; m < 4; ++m) { const size_t off = (size_t)(row0 + ai * HALF + m * 16) * 1024 + col0; const float rs = S[ai * HALF + wr * 64 + m * 16 + fr];
#pragma unroll
                for (int bj = 0; bj < 2; ++bj)
#pragma unroll
                    for (int n = 0; n < 2; ++n) *(f32x4*)(C + off + bj * HALF + n * 16) = acc[ai][bj][m][n] * rs * gv[bj][n]; }
        __syncthreads();
    }
};
template <class Epi, class Sched, bool STAMP = false>
__device__ __forceinline__ void gemm_phase(PG8_LAS unsigned char* lds, const Gemm g, const Sched& S, const Epi& E, unsigned long long* stamps) {
    const int tid = threadIdx.x, wid = __builtin_amdgcn_readfirstlane(tid >> 6), lane = tid & 63, wr = wid >> 2, wc = wid & 3, fr = lane & 15, fq = lane >> 4;
    const int K = g.K, nt = K / BK;
    int ts_lo = 0, ts_hi = 0, nts = 0; const unsigned long long rt_entry = STAMP ? (unsigned long long)wall_clock64() : 0ull;
#define PG8_STAMP() do { if (STAMP && wid == 0 && nts < 64) { const unsigned long long _c = (unsigned long long)clock64(); \
        ts_lo = (lane == nts) ? (int)(unsigned)_c : ts_lo; ts_hi = (lane == nts) ? (int)(unsigned)(_c >> 32) : ts_hi; ++nts; } } while (0)
    PG8_STAMP();
    unsigned voffA[2], voffB[2];
#pragma unroll
    for (int i = 0; i < 2; ++i) { int R, C; stage_rc(tid * 16 + i * 8192, R, C); const int Rb = Epi::PERM ? ((R & ~31) + perm32(R & 31)) : R;
        voffA[i] = (unsigned)(R * K + C) * 2u; voffB[i] = (unsigned)(Rb * K + C) * 2u; }
    const size_t kstep = (size_t)(BK * 2);
    const size_t hstep = (size_t)HALF * K * 2;
    const size_t tstep = 2 * hstep;
    const unsigned ldsw = (unsigned)wid * 1024u;
    const int aoff = lds_byte(wr * 64 + fr, fq * 8), boff = lds_byte(wc * 32 + fr, fq * 8);
#define PG8_SA(b, h) (((b) * 2 + (h)) * HTB)
#define PG8_SB(b, h) ((4 + (b) * 2 + (h)) * HTB)
#define PG8_STAGE(bufoff, gbase, voff) do { _Pragma("unroll") for (int _i = 0; _i < 2; ++_i) \
        __builtin_amdgcn_global_load_lds((const unsigned*)((const char*)(gbase) + (voff)[_i]), (PG8_LAS unsigned*)(lds + (bufoff) + ldsw + _i * 8192), 16, 0, 0); } while (0)
#define PG8_LDA(dst, b, h) do { _Pragma("unroll") for (int m = 0; m < 4; ++m) _Pragma("unroll") for (int k = 0; k < 2; ++k) dst[m][k] = *(const PG8_LAS bf16x8*)(lds + PG8_SA(b, h) + aoff + m * 2048 + k * 1024); } while (0)
#define PG8_LDB(dst, b, h) do { _Pragma("unroll") for (int n = 0; n < 2; ++n) _Pragma("unroll") for (int k = 0; k < 2; ++k) dst[n][k] = *(const PG8_LAS bf16x8*)(lds + PG8_SB(b, h) + boff + n * 2048 + k * 1024); } while (0)
#define PG8_MMA(ai, bj, At, Bt) do { __builtin_amdgcn_s_setprio(1); _Pragma("unroll") for (int m = 0; m < 4; ++m) _Pragma("unroll") for (int n = 0; n < 2; ++n) _Pragma("unroll") for (int k = 0; k < 2; ++k) \
        acc[ai][bj][m][n] = __builtin_amdgcn_mfma_f32_16x16x32_bf16(Bt[n][k], At[m][k], acc[ai][bj][m][n], 0, 0, 0); __builtin_amdgcn_s_setprio(0); } while (0)
#define PG8_WAIT_V(n) asm volatile("s_waitcnt vmcnt(" #n ")" ::: "memory")
#define PG8_WAIT_L(n) asm volatile("s_waitcnt lgkmcnt(" #n ")" ::: "memory")
#define PG8_BAR __builtin_amdgcn_s_barrier()
#define PG8_SCHED __builtin_amdgcn_sched_barrier(0)
    Unit cur, nxt; int ui = 0;
    if (!S.next(0, cur)) return;
    f32x4 acc[2][2][4][2];
#pragma unroll
    for (int a = 0; a < 2; ++a)
#pragma unroll
        for (int b = 0; b < 2; ++b)
#pragma unroll
            for (int m = 0; m < 4; ++m)
#pragma unroll
                for (int n = 0; n < 2; ++n) acc[a][b][m][n] = (f32x4){0.f, 0.f, 0.f, 0.f};
    bf16x8 At[4][2], B0[2][2], B1[2][2];
    const char* cA = (const char*)g.A + (size_t)cur.pm * tstep; const char* cB = (const char*)g.Bt + (size_t)cur.pn * tstep;
    S.a_ready(cur);
    PG8_STAGE(PG8_SB(0, 0), cB, voffB); PG8_STAGE(PG8_SA(0, 0), cA, voffA); PG8_STAGE(PG8_SB(0, 1), cB + hstep, voffB); PG8_STAGE(PG8_SA(0, 1), cA + hstep, voffA);
    if (wr == 1) PG8_BAR;
    PG8_WAIT_V(4); PG8_BAR;
    PG8_STAGE(PG8_SB(1, 0), cB + kstep, voffB); PG8_STAGE(PG8_SA(1, 0), cA + kstep, voffA); PG8_STAGE(PG8_SB(1, 1), cB + hstep + kstep, voffB);
    PG8_WAIT_V(6); PG8_BAR;
    PG8_STAMP();
    for (;;) {
        const bool has_next = S.next(ui + 1, nxt);
        const char* nA = has_next ? (const char*)g.A + (size_t)nxt.pm * tstep : cA; const char* nB = has_next ? (const char*)g.Bt + (size_t)nxt.pn * tstep : cB;
        for (int t = 0; t < nt; t += 2) {
            const bool last = (t == nt - 2);
            const char* a1 = cA + (size_t)(t + 1) * kstep;
            const char* a2 = last ? nA : cA + (size_t)(t + 2) * kstep; const char* b2 = last ? nB : cB + (size_t)(t + 2) * kstep;
            const char* a3 = a2 + kstep; const char* b3 = b2 + kstep;
            if (last && has_next) S.a_ready(nxt);
            PG8_LDB(B0, 0, 0); PG8_SCHED; PG8_LDA(At, 0, 0); PG8_STAGE(PG8_SA(1, 1), a1 + hstep, voffA);
            PG8_WAIT_L(8); PG8_BAR; PG8_WAIT_L(0); PG8_MMA(0, 0, At, B0); PG8_BAR; PG8_SCHED;
            PG8_LDB(B1, 0, 1); PG8_STAGE(PG8_SB(0, 0), b2, voffB);
            PG8_BAR; PG8_WAIT_L(0); PG8_MMA(0, 1, At, B1); PG8_BAR;
            PG8_LDA(At, 0, 1); PG8_STAGE(PG8_SA(0, 0), a2, voffA);
            PG8_BAR; PG8_WAIT_L(0); PG8_MMA(1, 0, At, B0); PG8_BAR; PG8_SCHED;
            PG8_STAGE(PG8_SB(0, 1), b2 + hstep, voffB);
            PG8_WAIT_V(6); PG8_BAR; PG8_MMA(1, 1, At, B1); PG8_BAR;
            PG8_LDB(B0, 1, 0); PG8_SCHED; PG8_LDA(At, 1, 0); PG8_STAGE(PG8_SA(0, 1), a2 + hstep, voffA);
            PG8_WAIT_L(8); PG8_BAR; PG8_WAIT_L(0); PG8_MMA(0, 0, At, B0); PG8_BAR; PG8_SCHED;
            PG8_LDB(B1, 1, 1); PG8_STAGE(PG8_SB(1, 0), b3, voffB);
            PG8_BAR; PG8_WAIT_L(0); PG8_MMA(0, 1, At, B1); PG8_BAR;
            PG8_LDA(At, 1, 1); PG8_STAGE(PG8_SA(1, 0), a3, voffA);
            PG8_BAR; PG8_WAIT_L(0); PG8_MMA(1, 0, At, B0); PG8_BAR; PG8_SCHED;
            PG8_STAGE(PG8_SB(1, 1), b3 + hstep, voffB);
            PG8_WAIT_V(6); PG8_BAR; PG8_MMA(1, 1, At, B1); PG8_BAR;
        }
        PG8_STAMP();
        if constexpr (!Epi::AFTER_DRAIN) { E(acc, cur, wr, wc, fr, fq); S.done(cur); }
        PG8_STAMP();
        if (!has_next) break;
#pragma unroll
        for (int a = 0; a < 2; ++a)
#pragma unroll
            for (int b = 0; b < 2; ++b)
#pragma unroll
                for (int m = 0; m < 4; ++m)
#pragma unroll
                    for (int n = 0; n < 2; ++n) acc[a][b][m][n] = (f32x4){0.f, 0.f, 0.f, 0.f};
        cur = nxt; cA = nA; cB = nB; ++ui;
    }
    PG8_WAIT_V(0);
    if (wr == 0) PG8_BAR;
    PG8_BAR;
    if constexpr (Epi::AFTER_DRAIN) { E.fused(acc, cur, wr, wc, fr, fq, lds, wid, lane); S.done(cur); }
    PG8_STAMP();
    if (STAMP && wid == 0) { stamps[lane] = lane < nts ? (((unsigned long long)(unsigned)ts_hi << 32) | (unsigned)ts_lo) : 0ull;
        if (lane == 62) stamps[62] = rt_entry; if (lane == 63) stamps[63] = (unsigned long long)wall_clock64(); }
#undef PG8_STAMP
#undef PG8_SA
#undef PG8_SB
#undef PG8_STAGE
#undef PG8_LDA
#undef PG8_LDB
#undef PG8_MMA
#undef PG8_WAIT_V
#undef PG8_WAIT_L
#undef PG8_BAR
#undef PG8_SCHED
}
}

using pg8::bf16_t;
typedef short bf16x8_t __attribute__((ext_vector_type(8)));
typedef float f32x4_t __attribute__((ext_vector_type(4)));

constexpr int NB = 8, SEQ = 8192, DM = 1024, DH = 768, NTOK = NB * SEQ;
constexpr size_t MiB = 1ull << 20;
constexpr size_t OFF_XN = 0, OFF_YHT = 0, OFF_HYT = 128 * MiB, OFF_YCAT = 128 * MiB, OFF_P2 = 416 * MiB, OFF_KF = 704 * MiB, OFF_KH = 752 * MiB,
                 OFF_HF = 784 * MiB, OFF_HB = 880 * MiB, OFF_WT1 = 976 * MiB, OFF_WT2 = 985 * MiB, OFF_PS = 988 * MiB, OFF_CTL = 990 * MiB, OFF_XBAR = OFF_CTL + 16384, OFF_CNT = OFF_CTL + 4096, OFF_ROWSQ = OFF_CTL + 65536, WS_END = 991 * MiB;
constexpr int NFFT = 16384;
constexpr int ZPHYS = NFFT + (NFFT / 64) * 4;
constexpr int LDS_BYTES = ZPHYS * 8 + 256;
constexpr int N_LRU_UNITS = 192, N_HY_UNITS = 768, N_HY_FULL = 640;
#ifndef MIX_SEL
#define MIX_SEL 0
#endif

struct Params { const float* in[27]; float* out; unsigned char* ws; int ph_lo, ph_hi; };

__device__ __forceinline__ float bf2f(unsigned short b) { return __uint_as_float(((unsigned)b) << 16); }
__device__ __forceinline__ float bflo(unsigned w) { return __uint_as_float(w << 16); }
__device__ __forceinline__ float bfhi(unsigned w) { return __uint_as_float(w & 0xffff0000u); }
__device__ __forceinline__ unsigned pk(float a, float b) { return pg8::cvt_pk_bf16(a, b); }
__device__ __forceinline__ float wave_sum(float v) {
#pragma unroll
    for (int o = 32; o; o >>= 1) v += __shfl_xor(v, o);
    return v; }
typedef unsigned u32x4_t __attribute__((ext_vector_type(4)));
typedef unsigned u32x2_t __attribute__((ext_vector_type(2)));
__device__ __forceinline__ uint4 ldnt4(const void* p) { const u32x4_t t = __builtin_nontemporal_load((const u32x4_t*)p); return make_uint4(t[0], t[1], t[2], t[3]); }
__device__ __forceinline__ uint2 ldnt2(const void* p) { const u32x2_t t = __builtin_nontemporal_load((const u32x2_t*)p); return make_uint2(t[0], t[1]); }
__device__ __forceinline__ unsigned ldnt1(const void* p) { return __builtin_nontemporal_load((const unsigned*)p); }
__device__ __forceinline__ float sigm(float x) { return __builtin_amdgcn_rcpf(1.0f + __expf(-x)); }
__device__ __forceinline__ float sin_rad(float x) { const float r = x * 0.15915494309189535f; return __builtin_amdgcn_sinf(r - floorf(r)); }
__device__ __forceinline__ float cos_rad(float x) { const float r = x * 0.15915494309189535f; return __builtin_amdgcn_cosf(r - floorf(r)); }

__device__ void phase_xn(const Params& p) {
    const int tid = threadIdx.x, lane = tid & 63, wid = tid >> 6;
    const float* x = p.in[0]; bf16_t* XN = (bf16_t*)(p.ws + OFF_XN);
    for (int row = (blockIdx.x * 8 + wid) * 4; row < NTOK; row += gridDim.x * 32) {
        float4 v[4][4]; float ss[4];
#pragma unroll
        for (int r = 0; r < 4; ++r) { const float4* src = (const float4*)(x + (size_t)(row + r) * DM);
#pragma unroll
            for (int i = 0; i < 4; ++i) { const f32x4_t t4 = __builtin_nontemporal_load((const f32x4_t*)src + i * 64 + lane); v[r][i] = make_float4(t4[0], t4[1], t4[2], t4[3]); } }
#pragma unroll
        for (int r = 0; r < 4; ++r) { float s = 0.f;
#pragma unroll
            for (int i = 0; i < 4; ++i) s += v[r][i].x * v[r][i].x + v[r][i].y * v[r][i].y + v[r][i].z * v[r][i].z + v[r][i].w * v[r][i].w;
            ss[r] = wave_sum(s); }
#pragma unroll
        for (int r = 0; r < 4; ++r) { const float rs = rsqrtf(ss[r] * (1.0f / DM) + 1e-6f); uint2* dst = (uint2*)(XN + (size_t)(row + r) * DM);
#pragma unroll
            for (int i = 0; i < 4; ++i) { uint2 w; w.x = pk(v[r][i].x * rs, v[r][i].y * rs); w.y = pk(v[r][i].z * rs, v[r][i].w * rs); dst[i * 64 + lane] = w; } }
    }
}
__device__ void transpose_to_bf16(const float* src, int R, int C, const float* rowscale, bf16_t* dst, float* tile) {
    const int tid = threadIdx.x; const int tc = C / 64, nt = (R / 64) * tc;
    for (int t = blockIdx.x; t < nt; t += gridDim.x) {
        const int r0 = (t / tc) * 64, c0 = (t % tc) * 64;
        __syncthreads();
#pragma unroll
        for (int i = 0; i < 2; ++i) { const int r = (tid >> 4) + 32 * i, c4 = (tid & 15) * 4;
            const float4 v = *(const float4*)(src + (size_t)(r0 + r) * C + c0 + c4); const float s = rowscale ? rowscale[r0 + r] : 1.0f;
            tile[r * 65 + c4 + 0] = v.x * s; tile[r * 65 + c4 + 1] = v.y * s; tile[r * 65 + c4 + 2] = v.z * s; tile[r * 65 + c4 + 3] = v.w * s; }
        __syncthreads();
        { const int c = tid >> 3, r8 = (tid & 7) * 8; float v[8];
#pragma unroll
          for (int e = 0; e < 8; ++e) v[e] = tile[(r8 + e) * 65 + c];
          uint4 w; w.x = pk(v[0], v[1]); w.y = pk(v[2], v[3]); w.z = pk(v[4], v[5]); w.w = pk(v[6], v[7]);
          *(uint4*)(dst + (size_t)(c0 + c) * R + r0 + r8) = w; }
    }
}
__device__ void phase_filter(const Params& p, unsigned char* lds) {
    const int tid = threadIdx.x;
    float* Z = (float*)lds; float* H1 = Z + 32 * 33; float* H2 = H1 + 2048; float* H3 = H2 + 2048;
    const float *w1 = p.in[5], *b1 = p.in[6], *f1 = p.in[7], *w2 = p.in[8], *b2 = p.in[9], *f2 = p.in[10], *w3 = p.in[11], *b3 = p.in[12], *f3 = p.in[13], *w4 = p.in[14];
    float* KF = (float*)(p.ws + OFF_KF); float* PS = (float*)(p.ws + OFF_PS);
    const float MIN_DECAY = -15.350567286626973f, MAX_DECAY = -3.0701134573253945f;
    for (int item = blockIdx.x; item < 256; item += gridDim.x) {
        const int j0 = item * 32;
        __syncthreads();
        for (int idx = tid; idx < 32 * 33; idx += 512) { const int row = idx / 33, i = idx % 33, j = j0 + row; float val;
            if (i == 0) val = (float)j * (1.0f / 8191.0f);
            else { const int m = (i - 1) & 15; const float fm = 1e-4f + (float)m * ((15.0f - 1e-4f) / 15.0f); const float wj = (float)j * (6.283185307179586f / 8192.0f); const float xx = wj * fm;
                val = (i <= 16) ? cos_rad(xx) : -sin_rad(xx); }
            Z[idx] = val; }
        __syncthreads();
        { int o = tid & 63; asm volatile("" : "+v"(o)); const int w8 = tid >> 6;
          { float wr[33];
#pragma unroll
            for (int i = 0; i < 33; ++i) wr[i] = w1[i * 64 + o];
            const float bo = b1[o], fo = f1[o];
#pragma unroll 1
            for (int k = 0; k < 4; ++k) { const int row = w8 + 8 * k; float acc = bo;
#pragma unroll
                for (int i = 0; i < 33; ++i) acc += Z[row * 33 + i] * wr[i];
                H1[row * 64 + o] = sin_rad(fo * acc); } }
          __syncthreads();
          { float wr[64];
#pragma unroll
            for (int i = 0; i < 64; ++i) wr[i] = w2[i * 64 + o];
            const float bo = b2[o], fo = f2[o];
#pragma unroll 1
            for (int k = 0; k < 4; ++k) { const int row = w8 + 8 * k; float acc = bo; const float4* h4 = (const float4*)(H1 + row * 64);
#pragma unroll
                for (int i4 = 0; i4 < 16; ++i4) { const float4 hv = h4[i4]; acc += hv.x * wr[4 * i4] + hv.y * wr[4 * i4 + 1] + hv.z * wr[4 * i4 + 2] + hv.w * wr[4 * i4 + 3]; }
                H2[row * 64 + o] = sin_rad(fo * acc); } }
          __syncthreads();
          { float wr[64];
#pragma unroll
            for (int i = 0; i < 64; ++i) wr[i] = w3[i * 64 + o];
            const float bo = b3[o], fo = f3[o];
#pragma unroll 1
            for (int k = 0; k < 4; ++k) { const int row = w8 + 8 * k; float acc = bo; const float4* h4 = (const float4*)(H2 + row * 64);
#pragma unroll
                for (int i4 = 0; i4 < 16; ++i4) { const float4 hv = h4[i4]; acc += hv.x * wr[4 * i4] + hv.y * wr[4 * i4 + 1] + hv.z * wr[4 * i4 + 2] + hv.w * wr[4 * i4 + 3]; }
                ((unsigned short*)H3)[row * 72 + o] = (unsigned short)(pk(sin_rad(fo * acc), 0.f) & 0xffffu); } }
          __syncthreads(); }
        { const int lane = tid & 63, wv = tid >> 6, g4 = lane >> 4, l16 = lane & 15; const bf16_t* H3B = (const bf16_t*)H3;
          bf16x8_t afr[2][2];
#pragma unroll
          for (int rt = 0; rt < 2; ++rt)
#pragma unroll
              for (int ks = 0; ks < 2; ++ks) afr[rt][ks] = *(const bf16x8_t*)(H3B + (16 * rt + l16) * 72 + 32 * ks + 8 * g4);
#pragma unroll 2
          for (int ctl = 0; ctl < 12; ++ctl) {
              const int cp = 16 * (wv * 12 + ctl) + l16;
              float wf[2][8];
#pragma unroll
              for (int ks = 0; ks < 2; ++ks)
#pragma unroll
                  for (int e = 0; e < 8; ++e) wf[ks][e] = w4[(32 * ks + 8 * g4 + e) * 1536 + cp];
              f32x4_t acc[2] = {{0.f, 0.f, 0.f, 0.f}, {0.f, 0.f, 0.f, 0.f}};
#pragma unroll
              for (int ks = 0; ks < 2; ++ks) { uint4 bw; bw.x = pk(wf[ks][0], wf[ks][1]); bw.y = pk(wf[ks][2], wf[ks][3]); bw.z = pk(wf[ks][4], wf[ks][5]); bw.w = pk(wf[ks][6], wf[ks][7]);
#pragma unroll
                  for (int rt = 0; rt < 2; ++rt) acc[rt] = __builtin_amdgcn_mfma_f32_16x16x32_bf16(afr[rt][ks], __builtin_bit_cast(bf16x8_t, bw), acc[rt], 0, 0, 0); }
              const bool bwd = cp >= DH; const int c = bwd ? cp - DH : cp;
              const float ad = fabsf(MIN_DECAY + (float)c * ((MAX_DECAY - MIN_DECAY) / 767.0f));
              float asum = 0.f; float* kc = KF + (size_t)c * NFFT + (bwd ? SEQ : 0);
#pragma unroll
              for (int rt = 0; rt < 2; ++rt) { float v[4];
#pragma unroll
                  for (int jj = 0; jj < 4; ++jj) { const int j = j0 + 16 * rt + 4 * g4 + jj; const float tj = (float)j * (1.0f / 8191.0f); v[jj] = acc[rt][jj] * __expf(-tj * ad); if (!bwd || j >= 1) asum += fabsf(v[jj]); }
                  *(float4*)(kc + j0 + 16 * rt + 4 * g4) = make_float4(v[0], v[1], v[2], v[3]); }
              asum += __shfl_xor(asum, 16); asum += __shfl_xor(asum, 32);
              if (g4 == 0) PS[item * 1536 + cp] = asum;
          } }
    }
}
__device__ void phase0(const Params& p, unsigned char* lds) {
    { float* rq = (float*)(p.ws + OFF_ROWSQ); for (int i = blockIdx.x * 512 + threadIdx.x; i < NTOK; i += gridDim.x * 512) rq[i] = 0.f; }
    const bool filter_first = (blockIdx.x & 1) != 0;
    if (filter_first) { phase_filter(p, lds); __syncthreads(); }
    phase_xn(p);
    transpose_to_bf16(p.in[2], DM, 4608, p.in[1], (bf16_t*)(p.ws + OFF_WT1), (float*)lds);
    transpose_to_bf16(p.in[25], 1536, DM, nullptr, (bf16_t*)(p.ws + OFF_WT2), (float*)lds);
    if (!filter_first) phase_filter(p, lds);
}
__device__ void phase_gemm1(const Params& p, unsigned char* lds) {
    PG8_LAS unsigned char* l3 = (PG8_LAS unsigned char*)lds;
    const bf16_t* XN = (const bf16_t*)(p.ws + OFF_XN); const bf16_t* WT1 = (const bf16_t*)(p.ws + OFF_WT1);
#pragma unroll 1
    for (int pass = 0; pass < 2; ++pass) {
        int ps = pass; asm volatile("" : "+s"(ps));
        pg8::StaticOrder S; pg8::Gemm g; pg8::EpiStoreBf16 E;
        g.A = ps ? XN : WT1; g.Bt = ps ? WT1 + (size_t)2304 * DM : XN; g.M = ps ? NTOK : 2304; g.N = ps ? 2304 : NTOK; g.K = DM;
        E.O = (bf16_t*)(p.ws + (ps ? OFF_P2 : OFF_HYT)); E.ldc = g.N;
        S.init(g.M, g.N, (int)gridDim.x, (int)blockIdx.x);
        pg8::gemm_phase<pg8::EpiStoreBf16, pg8::StaticOrder, false>(l3, g, S, E, nullptr);
        __syncthreads();
    }
}
__device__ void phase_gemm2(const Params& p, unsigned char* lds) {
    PG8_LAS unsigned char* l3 = (PG8_LAS unsigned char*)lds;
    pg8::Gemm g{(const bf16_t*)(p.ws + OFF_YCAT), (const bf16_t*)(p.ws + OFF_WT2), NTOK, DM, 1536};
    pg8::EpiFinal E{p.out, p.in[0], p.in[26], (float*)(p.ws + OFF_ROWSQ), (unsigned*)(p.ws + OFF_CNT)};
    const int G = (int)gridDim.x;
#pragma unroll 1
    for (int L = (int)blockIdx.x; L < 1024; L += G) {
        pg8::OneUnit S;
        if (G == 256) { const int r = L >> 8, c = L & 255, x = c & 7, t = c >> 3; S.pm = 64 * r + x * 8 + (t >> 2); S.pn = t & 3; }
        else { S.pm = L >> 2; S.pn = L & 3; }
        pg8::gemm_phase<pg8::EpiFinal, pg8::OneUnit, false>(l3, g, S, E, nullptr);
        __syncthreads();
    }
}
typedef float v2 __attribute__((ext_vector_type(2)));
__device__ __forceinline__ int phys(int e) { return e + ((e >> 5) << 1); }
__device__ __forceinline__ v2 cmulv(v2 a, v2 b) { v2 t, r;
    asm("v_pk_mul_f32 %0, %1, %2 op_sel:[0,0] op_sel_hi:[0,1]" : "=v"(t) : "v"(a), "v"(b));
    asm("v_pk_fma_f32 %0, %1, %2, %3 op_sel:[1,1,0] op_sel_hi:[1,0,1] neg_lo:[0,1,0]" : "=v"(r) : "v"(a), "v"(b), "v"(t));
    return r; }
template <int SGN> __device__ __forceinline__ void addsub_rot(v2 a, v2 b, v2& p, v2& m) {
    if (SGN < 0) { asm("v_pk_add_f32 %0, %1, %2 op_sel:[0,1] op_sel_hi:[1,0] neg_hi:[0,1]" : "=v"(p) : "v"(a), "v"(b));
                   asm("v_pk_add_f32 %0, %1, %2 op_sel:[0,1] op_sel_hi:[1,0] neg_lo:[0,1]" : "=v"(m) : "v"(a), "v"(b)); }
    else         { asm("v_pk_add_f32 %0, %1, %2 op_sel:[0,1] op_sel_hi:[1,0] neg_lo:[0,1]" : "=v"(p) : "v"(a), "v"(b));
                   asm("v_pk_add_f32 %0, %1, %2 op_sel:[0,1] op_sel_hi:[1,0] neg_hi:[0,1]" : "=v"(m) : "v"(a), "v"(b)); }
}
__device__ __forceinline__ constexpr float c16(int k) { return k == 0 ? 1.0f : k == 1 ? 0.9238795325112867f : k == 2 ? 0.7071067811865476f : k == 3 ? 0.3826834323650898f : k == 4 ? 0.0f : k == 6 ? -0.7071067811865476f : k == 9 ? -0.9238795325112867f : 0.0f; }
__device__ __forceinline__ constexpr float s16(int k) { return k == 0 ? 0.0f : k == 1 ? 0.3826834323650898f : k == 2 ? 0.7071067811865476f : k == 3 ? 0.9238795325112867f : k == 4 ? 1.0f : k == 6 ? 0.7071067811865476f : k == 9 ? -0.3826834323650898f : 0.0f; }
template <int SGN> __device__ __forceinline__ void bfly4(v2& a0, v2& a1, v2& a2, v2& a3) {
    const v2 t0 = a0 + a2, t1 = a0 - a2, t2 = a1 + a3, t3 = a1 - a3;
    a0 = t0 + t2; a2 = t0 - t2; addsub_rot<SGN>(t1, t3, a1, a3);
}
template <int SGN> __device__ __forceinline__ void dft16(v2 (&x)[16]) {
#pragma unroll
    for (int q2 = 0; q2 < 4; ++q2) bfly4<SGN>(x[q2], x[q2 + 4], x[q2 + 8], x[q2 + 12]);
#pragma unroll
    for (int q2 = 1; q2 < 4; ++q2)
#pragma unroll
        for (int r1 = 1; r1 < 4; ++r1) { const int k = q2 * r1; const v2 w = {c16(k), (float)SGN * s16(k)}; x[q2 + 4 * r1] = cmulv(x[q2 + 4 * r1], w); }
#pragma unroll
    for (int r1 = 0; r1 < 4; ++r1) bfly4<SGN>(x[4 * r1], x[4 * r1 + 1], x[4 * r1 + 2], x[4 * r1 + 3]);
}
#define FFT_TW_CHAIN() v2 tw[16]; { const float ang = (float)j * (1.0f / (float)M); const float sn = __builtin_amdgcn_sinf(ang), cs = __builtin_amdgcn_cosf(ang); \
          tw[0] = (v2){1.f, 0.f}; tw[1] = (v2){cs, (float)SGN * sn}; tw[2] = cmulv(tw[1], tw[1]); tw[3] = cmulv(tw[2], tw[1]); tw[4] = cmulv(tw[2], tw[2]); tw[5] = cmulv(tw[4], tw[1]); tw[6] = cmulv(tw[3], tw[3]); tw[7] = cmulv(tw[4], tw[3]); \
          tw[8] = cmulv(tw[4], tw[4]); tw[9] = cmulv(tw[8], tw[1]); tw[10] = cmulv(tw[5], tw[5]); tw[11] = cmulv(tw[8], tw[3]); tw[12] = cmulv(tw[6], tw[6]); tw[13] = cmulv(tw[8], tw[5]); tw[14] = cmulv(tw[7], tw[7]); tw[15] = cmulv(tw[8], tw[7]); }
template <int M, int SGN, int HALF> __device__ __forceinline__ void fft_pass16(v2* z, int tid) {
    constexpr int S = M / 16; constexpr int PS = (S >= 64) ? S + S / 16 : S;
#pragma unroll 1
    for (int it = 0; it < 2; ++it) {
        int t = tid + it * 512; asm volatile("" : "+v"(t)); const int j = t & (S - 1); const int base = (t / S) * M;
        v2* zp = z + phys(base + j);
        v2 x[16];
#pragma unroll
        for (int q = 0; q < 16; ++q) x[q] = (HALF && SGN < 0 && q >= 8) ? (v2){0.f, 0.f} : zp[q * PS];
        const float ang = (float)j * (1.0f / (float)M); const v2 w1 = {__builtin_amdgcn_cosf(ang), (float)SGN * __builtin_amdgcn_sinf(ang)};
        if (SGN > 0) { v2 w = w1;
#pragma unroll
            for (int q = 1; q < 16; ++q) { x[q] = cmulv(x[q], w); if (q < 15) w = cmulv(w, w1); }
            dft16<SGN>(x);
#pragma unroll
            for (int pp = 0; pp < 16; ++pp) { const int r = (pp >> 2) + 4 * (pp & 3); if (HALF && r >= 8) continue; zp[r * PS] = x[pp]; }
        } else {
            dft16<SGN>(x);
            v2 w = w1; zp[0] = x[0];
#pragma unroll
            for (int r = 1; r < 16; ++r) { const int pp = 4 * (r & 3) + (r >> 2); zp[r * PS] = cmulv(x[pp], w); if (r < 15) w = cmulv(w, w1); }
        }
    }
}
__device__ __forceinline__ constexpr float c32(int k) { return k == 0 ? 1.0f : k == 1 ? 0.9807852804032304f : k == 2 ? 0.9238795325112867f : k == 3 ? 0.8314696123025452f : k == 4 ? 0.7071067811865476f : k == 5 ? 0.5555702330196022f : k == 6 ? 0.3826834323650898f : k == 7 ? 0.1950903220161283f : k == 8 ? 0.0f
    : k == 9 ? -0.1950903220161283f : k == 10 ? -0.3826834323650898f : k == 11 ? -0.5555702330196022f : k == 12 ? -0.7071067811865476f : k == 13 ? -0.8314696123025452f : k == 14 ? -0.9238795325112867f : -0.9807852804032304f; }
__device__ __forceinline__ constexpr float s32(int k) { return k == 0 ? 0.0f : k == 1 ? 0.1950903220161283f : k == 2 ? 0.3826834323650898f : k == 3 ? 0.5555702330196022f : k == 4 ? 0.7071067811865476f : k == 5 ? 0.8314696123025452f : k == 6 ? 0.9238795325112867f : k == 7 ? 0.9807852804032304f : k == 8 ? 1.0f
    : k == 9 ? 0.9807852804032304f : k == 10 ? 0.9238795325112867f : k == 11 ? 0.8314696123025452f : k == 12 ? 0.7071067811865476f : k == 13 ? 0.5555702330196022f : k == 14 ? 0.3826834323650898f : 0.1950903220161283f; }
template <int SGN> __device__ __forceinline__ void dft32(v2 (&x)[32]) {
    v2 E[16], O[16];
#pragma unroll
    for (int i = 0; i < 16; ++i) { E[i] = x[2 * i]; O[i] = x[2 * i + 1]; }
    dft16<SGN>(E); dft16<SGN>(O);
#pragma unroll
    for (int k = 0; k < 16; ++k) { const int pp = 4 * (k & 3) + (k >> 2); v2 o = O[pp];
        if (k > 0) { const v2 w = {c32(k), (float)SGN * s32(k)}; o = cmulv(o, w); }
        x[k] = E[pp] + o; x[k + 16] = E[pp] - o; }
}
template <int SGN> __device__ __forceinline__ void fft_pass32(v2* z, int tid) {
    int t = tid; asm volatile("" : "+v"(t)); const int j = t & 31; v2* zp = z + phys((t >> 5) * 1024 + j);
    v2 x[32];
#pragma unroll
    for (int q = 0; q < 32; ++q) x[q] = zp[34 * q];
    const float ang = (float)j * (1.0f / 1024.0f); const v2 w1 = {__builtin_amdgcn_cosf(ang), (float)SGN * __builtin_amdgcn_sinf(ang)};
    if (SGN > 0) { v2 w = w1;
#pragma unroll
        for (int q = 1; q < 32; ++q) { x[q] = cmulv(x[q], w); if (q < 31) w = cmulv(w, w1); }
        dft32<SGN>(x);
#pragma unroll
        for (int q = 0; q < 32; ++q) zp[34 * q] = x[q];
    } else {
        dft32<SGN>(x);
        v2 w = w1; zp[0] = x[0];
#pragma unroll
        for (int r = 1; r < 32; ++r) { zp[34 * r] = cmulv(x[r], w); if (r < 31) w = cmulv(w, w1); }
    }
}
__device__ __forceinline__ void ld32(const v2* z, int tid, v2 (&x)[32]) { const float4* s = (const float4*)(z + phys(32 * tid));
#pragma unroll
    for (int i = 0; i < 16; ++i) { const float4 a = s[i]; x[2 * i] = (v2){a.x, a.y}; x[2 * i + 1] = (v2){a.z, a.w}; } }
__device__ __forceinline__ void st32(v2* z, int tid, const v2 (&x)[32]) { float4* s = (float4*)(z + phys(32 * tid));
#pragma unroll
    for (int i = 0; i < 16; ++i) s[i] = make_float4(x[2 * i].x, x[2 * i].y, x[2 * i + 1].x, x[2 * i + 1].y); }
struct In6 { uint2 w; unsigned halo; };
__device__ __forceinline__ In6 ld6(const bf16_t* seq, int l4) { In6 r; r.w = *(const uint2*)(seq + l4); const unsigned lo = l4 > 0 ? seq[l4 - 1] : 0u, hi = (l4 + 4 < SEQ) ? seq[l4 + 4] : 0u; r.halo = lo | (hi << 16); return r; }
__device__ __forceinline__ void conv3(const In6& in, float w0, float w1, float w2, float bb, float (&o)[4]) {
    const float i0 = bflo(in.halo), i1 = bflo(in.w.x), i2 = bfhi(in.w.x), i3 = bflo(in.w.y), i4 = bfhi(in.w.y), i5 = bfhi(in.halo);
    o[0] = bb + w0 * i0 + w1 * i1 + w2 * i2; o[1] = bb + w0 * i1 + w1 * i2 + w2 * i3; o[2] = bb + w0 * i2 + w1 * i3 + w2 * i4; o[3] = bb + w0 * i3 + w1 * i4 + w2 * i5;
}
__device__ void hyena_unit(const Params& p, unsigned char* lds, int c, int pr_lo, int pr_hi) {
    int tid = threadIdx.x; asm volatile("" : "+v"(tid)); const int lane = tid & 63, wid = tid >> 6;
    v2* z = (v2*)lds; float* red = (float*)(lds + ZPHYS * 8);
    const bf16_t* HYT = (const bf16_t*)(p.ws + OFF_HYT); bf16_t* YHT = (bf16_t*)(p.ws + OFF_YHT);
    const float* PS = (const float*)(p.ws + OFF_PS); const float* kf = (const float*)(p.ws + OFF_KF) + (size_t)c * NFFT;
    __syncthreads();
    { float part = 0.f; if (tid < 256) part = PS[tid * 1536 + c] + PS[tid * 1536 + DH + c];
      part = wave_sum(part); if (lane == 0 && wid < 4) red[wid] = part; }
    { float4 kv[8];
#pragma unroll
      for (int it = 0; it < 8; ++it) { const int e4 = (tid + 512 * it) * 4;
          if (it < 4) kv[it] = *(const float4*)(kf + e4);
          else { const float* q = kf + (3 * SEQ - e4); kv[it] = make_float4(e4 == SEQ ? 0.f : q[0], q[-1], q[-2], q[-3]); } }
      __syncthreads();
      const float scale = 1.0f / ((red[0] + red[1] + red[2] + red[3] + 1e-6f) * (float)NFFT);
#pragma unroll
      for (int it = 0; it < 8; ++it) { const int e4 = (tid + 512 * it) * 4; float4* d = (float4*)(z + phys(e4));
          d[0] = make_float4(kv[it].x * scale, 0.f, kv[it].y * scale, 0.f); d[1] = make_float4(kv[it].z * scale, 0.f, kv[it].w * scale, 0.f); } }
    __syncthreads();
    unsigned pw;
    { const int sq = tid >> 7; const bf16_t* sp = HYT + (size_t)((sq & 1) ? 2 * DH + c : c) * NTOK + (size_t)(2 * pr_lo + (sq >> 1)) * SEQ; pw = *(const unsigned*)((const char*)sp + (tid & 127) * 128); }
    fft_pass16<16384, -1, 0>(z, tid); __syncthreads(); fft_pass32<-1>(z, tid); __syncthreads();
    if (pw == 0x9e3779b9u) red[9] = 1.f;
    v2 kh[32];
    ld32(z, tid, kh); dft32<-1>(kh);
    const float* cw = p.in[3]; const float* cb = p.in[4];
    const float wv0 = cw[c], wv1 = cw[2304 + c], wv2 = cw[4608 + c], bv = cb[c];
    const float wa0 = cw[DH + c], wa1 = cw[2304 + DH + c], wa2 = cw[4608 + DH + c], ba = cb[DH + c];
    const float wb0 = cw[2 * DH + c], wb1 = cw[2304 + 2 * DH + c], wb2 = cw[4608 + 2 * DH + c], bbq = cb[2 * DH + c];
    const float dskip = p.in[15][c];
    const bf16_t* sv = HYT + (size_t)c * NTOK; const bf16_t* sx0 = HYT + (size_t)(DH + c) * NTOK; const bf16_t* sx1 = HYT + (size_t)(2 * DH + c) * NTOK;
#pragma unroll 1
    for (int pr = pr_lo; pr < pr_hi; ++pr) {
        const size_t o0 = (size_t)(2 * pr) * SEQ, o1 = o0 + SEQ;
        int tl = tid; asm volatile("" : "+v"(tl));
        unsigned uu[16];
        __syncthreads();
#pragma unroll
        for (int hh = 0; hh < 2; ++hh) { In6 a[2], b[2], cc[2], d[2];
#pragma unroll
          for (int i2 = 0; i2 < 2; ++i2) { const int it = 2 * hh + i2; const int l4 = (tl + 512 * it) * 4; a[i2] = ld6(sv + o0, l4); b[i2] = ld6(sx1 + o0, l4); cc[i2] = ld6(sv + o1, l4); d[i2] = ld6(sx1 + o1, l4); }
#pragma unroll
          for (int i2 = 0; i2 < 2; ++i2) { const int it = 2 * hh + i2; const int l4 = (tl + 512 * it) * 4; float v0[4], x10[4], v1[4], x11[4];
              conv3(a[i2], wv0, wv1, wv2, bv, v0); conv3(b[i2], wb0, wb1, wb2, bbq, x10); conv3(cc[i2], wv0, wv1, wv2, bv, v1); conv3(d[i2], wb0, wb1, wb2, bbq, x11);
#pragma unroll
              for (int s = 0; s < 4; ++s) { v0[s] *= x10[s]; v1[s] *= x11[s]; uu[4 * it + s] = pk(v0[s], v1[s]); }
              float4* dd = (float4*)(z + phys(l4));
              dd[0] = make_float4(v0[0], v1[0], v0[1], v1[1]); dd[1] = make_float4(v0[2], v1[2], v0[3], v1[3]); }
          __builtin_amdgcn_sched_barrier(0); }
        __syncthreads();
        fft_pass16<16384, -1, 1>(z, tid); __syncthreads(); fft_pass32<-1>(z, tid); __syncthreads();
        { v2 x[32]; ld32(z, tl, x); dft32<-1>(x);
#pragma unroll
          for (int r = 0; r < 32; ++r) x[r] = cmulv(x[r], kh[r]);
          dft32<1>(x); st32(z, tl, x); }
        __syncthreads();
        unsigned pf0, pf1;
        { const size_t on = (pr + 1 < pr_hi) ? o0 + 2 * SEQ : o0; const int sq = tid >> 7;
          const bf16_t* sp = ((sq & 1) ? sx1 : sv) + on + (sq >> 1) * SEQ; pf0 = *(const unsigned*)((const char*)sp + (tid & 127) * 128);
          const bf16_t* sp2 = sx0 + o0 + (sq & 1) * SEQ; pf1 = *(const unsigned*)((const char*)sp2 + (tid & 127) * 128); }
        fft_pass32<1>(z, tid); __syncthreads();
        fft_pass16<16384, 1, 1>(z, tid);
        In6 ea[4], eb[4];
#pragma unroll
        for (int it = 0; it < 4; ++it) { const int l4 = (tl + 512 * it) * 4; ea[it] = ld6(sx0 + o0, l4); eb[it] = ld6(sx0 + o1, l4); }
        __syncthreads();
#pragma unroll
        for (int it = 0; it < 4; ++it) { const int l4 = (tl + 512 * it) * 4; float x00[4], x01[4];
            conv3(ea[it], wa0, wa1, wa2, ba, x00); conv3(eb[it], wa0, wa1, wa2, ba, x01);
            const float4* s = (const float4*)(z + phys(l4)); const float4 a = s[0], b = s[1];
            const float cv0[4] = {a.x, a.z, b.x, b.z}, cv1[4] = {a.y, a.w, b.y, b.w};
            float y0[4], y1[4];
#pragma unroll
            for (int s4 = 0; s4 < 4; ++s4) { y0[s4] = x00[s4] * (cv0[s4] + dskip * bflo(uu[4 * it + s4])); y1[s4] = x01[s4] * (cv1[s4] + dskip * bfhi(uu[4 * it + s4])); }
            uint2 w0; w0.x = pk(y0[0], y0[1]); w0.y = pk(y0[2], y0[3]); uint2 w1; w1.x = pk(y1[0], y1[1]); w1.y = pk(y1[2], y1[3]);
            *(uint2*)(YHT + (size_t)c * NTOK + o0 + l4) = w0; *(uint2*)(YHT + (size_t)c * NTOK + o1 + l4) = w1; }
        if ((pf0 ^ pf1) == 0x9e3779b9u) red[8] = 1.f;
    }
}
__device__ void lru_unit(const Params& p, unsigned char* lds, int unit) {
    int tid = threadIdx.x; asm volatile("" : "+v"(tid)); const int lane = tid & 63, wid = __builtin_amdgcn_readfirstlane(tid >> 6);
    const int dir = unit / 96, rem = unit % 96, b = rem / 12, h = rem % 12;
    bf16_t* INs = (bf16_t*)lds + wid * (20 * 64);
    bf16_t* XB = (bf16_t*)(lds + 20480);
    float* AA = (float*)(lds + 38912);
    float* BB = (float*)(lds + 73728);
    float2* CAR = (float2*)(lds + 108544);
    float* HC = (float*)(lds + 116736);
    uint4* WB = (uint4*)(lds + 117248);
    float* CWL = (float*)(lds + 133632);
    const bf16_t* src = (const bf16_t*)(p.ws + OFF_P2) + (size_t)b * SEQ * 2304 + DH + h * 64;
    bf16_t* dst = (bf16_t*)(p.ws + (dir ? OFF_HB : OFF_HF)) + (size_t)b * SEQ * DH + h * 64;
    const float* wa = p.in[18] + (size_t)(dir * 12 + h) * 4096; const float* wx = p.in[20] + (size_t)(dir * 12 + h) * 4096;
    __syncthreads();
    for (int entry = tid; entry < 1024; entry += 512) { const int f = entry >> 6, ln = entry & 63, g = f >> 3, ct = (f >> 1) & 3, ks = f & 1; const int k0 = 32 * ks + 8 * (ln >> 4), col = 16 * ct + (ln & 15);
        const float* W = g ? wx : wa; float v[8];
#pragma unroll
        for (int e = 0; e < 8; ++e) v[e] = -1.4426950408889634f * W[(k0 + e) * 64 + col];
        uint4 w; w.x = pk(v[0], v[1]); w.y = pk(v[2], v[3]); w.z = pk(v[4], v[5]); w.w = pk(v[6], v[7]); WB[entry] = w; }
    if (tid < 128) HC[tid] = 0.f;
    if (tid < 320) { const int k = tid >> 6, ch = h * 64 + (tid & 63); CWL[tid] = (k < 4) ? p.in[16][k * DH + ch] : p.in[17][ch]; }
    const int oct = lane & 7, rl0 = lane >> 3;
    const int q = dir ? 7 - wid : wid;
    float gba[4], gbx[4], sp8[4];
#pragma unroll
    for (int ct = 0; ct < 4; ++ct) { const int ch = dir * DH + h * 64 + 16 * ct + (lane & 15); gba[ct] = -1.4426950408889634f * p.in[19][ch]; gbx[ct] = -1.4426950408889634f * p.in[21][ch];
        const float e = __expf(-p.in[22][ch]); const float sp = (e < 0.02f) ? e * (1.0f - e * (0.5f - e * (1.0f / 3.0f))) : __logf(1.0f + e); sp8[ct] = 8.0f * 1.4426950408889634f * sp; }
    uint4 R[3];
#define LRU_ISSUE(l0v) { _Pragma("unroll") for (int i = 0; i < 3; ++i) { const int item = lane + 64 * i, r = item >> 3, o = item & 7, l = (l0v) - 1 + 16 * wid + r; const bool ok = (item < 152) && l >= 0 && l < SEQ; \
        R[i] = ok ? *(const uint4*)(src + (size_t)l * 2304 + o * 8) : make_uint4(0u, 0u, 0u, 0u); } }
    LRU_ISSUE(dir ? SEQ - 128 : 0)
    __syncthreads();
    float cwr[5][8];
#pragma unroll
    for (int k = 0; k < 5; ++k) { const float4 c0 = *(const float4*)(CWL + k * 64 + oct * 8), c1 = *(const float4*)(CWL + k * 64 + oct * 8 + 4);
        cwr[k][0] = c0.x; cwr[k][1] = c0.y; cwr[k][2] = c0.z; cwr[k][3] = c0.w; cwr[k][4] = c1.x; cwr[k][5] = c1.y; cwr[k][6] = c1.z; cwr[k][7] = c1.w; }
#pragma unroll 1
    for (int T = 0; T < 64; ++T) {
        const int l0 = dir ? SEQ - 128 * (T + 1) : 128 * T;
#pragma unroll
        for (int i = 0; i < 3; ++i) { const int item = lane + 64 * i; if (item < 160) *(uint4*)(INs + (item >> 3) * 64 + (item & 7) * 8) = R[i]; }
        asm volatile("" ::: "memory");
        if (T + 1 < 64) LRU_ISSUE(dir ? SEQ - 128 * (T + 2) : 128 * (T + 1))
#pragma unroll
        for (int i = 0; i < 2; ++i) { const int rl = rl0 + 8 * i; float acc[8];
#pragma unroll
            for (int e = 0; e < 8; ++e) acc[e] = cwr[4][e];
#pragma unroll
            for (int k = 0; k < 4; ++k) { const uint4 w = *(const uint4*)(INs + (rl + k) * 64 + oct * 8);
                acc[0] += cwr[k][0] * bflo(w.x); acc[1] += cwr[k][1] * bfhi(w.x); acc[2] += cwr[k][2] * bflo(w.y); acc[3] += cwr[k][3] * bfhi(w.y);
                acc[4] += cwr[k][4] * bflo(w.z); acc[5] += cwr[k][5] * bfhi(w.z); acc[6] += cwr[k][6] * bflo(w.w); acc[7] += cwr[k][7] * bfhi(w.w); }
            uint4 o; o.x = pk(acc[0], acc[1]); o.y = pk(acc[2], acc[3]); o.z = pk(acc[4], acc[5]); o.w = pk(acc[6], acc[7]);
            *(uint4*)(XB + (16 * wid + rl) * 72 + oct * 8) = o; }
        asm volatile("" ::: "memory");
        { const int rowA = 16 * wid + (lane & 15);
          const bf16x8_t a0 = *(const bf16x8_t*)(XB + rowA * 72 + 8 * (lane >> 4)), a1 = *(const bf16x8_t*)(XB + rowA * 72 + 32 + 8 * (lane >> 4));
          const int firstrow = dir ? 127 : 0;
#pragma unroll
          for (int ct = 0; ct < 4; ++ct) {
              f32x4_t accA = {gba[ct], gba[ct], gba[ct], gba[ct]}, accX = {gbx[ct], gbx[ct], gbx[ct], gbx[ct]};
              const uint4 b0 = WB[((0 * 4 + ct) * 2 + 0) * 64 + lane], b1 = WB[((0 * 4 + ct) * 2 + 1) * 64 + lane], b2 = WB[((1 * 4 + ct) * 2 + 0) * 64 + lane], b3 = WB[((1 * 4 + ct) * 2 + 1) * 64 + lane];
              accA = __builtin_amdgcn_mfma_f32_16x16x32_bf16(a0, __builtin_bit_cast(bf16x8_t, b0), accA, 0, 0, 0);
              accA = __builtin_amdgcn_mfma_f32_16x16x32_bf16(a1, __builtin_bit_cast(bf16x8_t, b1), accA, 0, 0, 0);
              accX = __builtin_amdgcn_mfma_f32_16x16x32_bf16(a0, __builtin_bit_cast(bf16x8_t, b2), accX, 0, 0, 0);
              accX = __builtin_amdgcn_mfma_f32_16x16x32_bf16(a1, __builtin_bit_cast(bf16x8_t, b3), accX, 0, 0, 0);
              const int ch = 16 * ct + (lane & 15);
#pragma unroll
              for (int j = 0; j < 4; ++j) { const int row = 16 * wid + 4 * (lane >> 4) + j;
                  const float r = __builtin_amdgcn_rcpf(1.0f + __builtin_amdgcn_exp2f(accA[j])), ig = __builtin_amdgcn_rcpf(1.0f + __builtin_amdgcn_exp2f(accX[j]));
                  const float a = __builtin_amdgcn_exp2f(-sp8[ct] * r); float mult = __builtin_amdgcn_sqrtf(fmaxf(1.0f - a * a, 0.f));
                  if (T == 0 && row == firstrow) mult = 1.0f;
                  const float xbv = bf2f(XB[row * 72 + ch]);
                  AA[row * 68 + ch] = a; BB[row * 68 + ch] = mult * ig * xbv; } } }
        asm volatile("" ::: "memory");
        { float av[16], bv[16]; float P = 1.f, H = 0.f;
#pragma unroll
          for (int s = 0; s < 16; ++s) { const int row = 16 * wid + (dir ? 15 - s : s); av[s] = AA[row * 68 + lane]; bv[s] = BB[row * 68 + lane]; H = av[s] * H + bv[s]; P *= av[s]; }
          CAR[((T & 1) * 8 + q) * 64 + lane] = make_float2(P, H);
          __syncthreads();
          float hin = HC[(T & 1) * 64 + lane];
          for (int s2 = 0; s2 < q; ++s2) { const float2 c2 = CAR[((T & 1) * 8 + s2) * 64 + lane]; hin = c2.x * hin + c2.y; }
#pragma unroll
          for (int s = 0; s < 16; ++s) { const int row = 16 * wid + (dir ? 15 - s : s); hin = av[s] * hin + bv[s]; dst[(size_t)(l0 + row) * DH + lane] = (bf16_t)(pk(hin, hin) & 0xffffu); }
          if (q == 7) HC[((T + 1) & 1) * 64 + lane] = hin; }
    }
#undef LRU_ISSUE
}
__device__ void phase_mix(const Params& p, unsigned char* lds, int which, int skip = 0) {
    unsigned* ctr = (unsigned*)(p.ws + OFF_CTL) + which; volatile int* slot = (volatile int*)(lds + LDS_BYTES - 16);
    for (;;) {
        __syncthreads();
        if (threadIdx.x == 0) *slot = (int)atomicAdd(ctr, 1u);
        __syncthreads();
        const int u = __builtin_amdgcn_readfirstlane(*slot);
        if (u >= N_LRU_UNITS + N_HY_FULL + 2 * (N_HY_UNITS - N_HY_FULL)) break;
        if (u < N_LRU_UNITS) { if (skip != 1) lru_unit(p, lds, u); }
        else if (skip != 2) { const int v = u - N_LRU_UNITS;
            if (v < N_HY_FULL) hyena_unit(p, lds, v, 0, 4);
            else { const int w = v - N_HY_FULL; hyena_unit(p, lds, N_HY_FULL + (w >> 1), (w & 1) * 2, (w & 1) * 2 + 2); } }
    }
}
__device__ void phase_ycat(const Params& p, unsigned char* lds) {
    const int tid = threadIdx.x, lane = tid & 63, wid = tid >> 6;
    unsigned* T = (unsigned*)lds; const unsigned short* Th = (const unsigned short*)lds;
    const bf16_t* YHT = (const bf16_t*)(p.ws + OFF_YHT); const bf16_t* P2 = (const bf16_t*)(p.ws + OFF_P2);
    const bf16_t* HF = (const bf16_t*)(p.ws + OFF_HF); const bf16_t* HB = (const bf16_t*)(p.ws + OFF_HB); bf16_t* YC = (bf16_t*)(p.ws + OFF_YCAT);
    float hg[12], lg[12];
#pragma unroll
    for (int m = 0; m < 6; ++m) { hg[2 * m] = p.in[23][2 * lane + 128 * m]; hg[2 * m + 1] = p.in[23][2 * lane + 128 * m + 1]; }
#pragma unroll
    for (int m = 0; m < 3; ++m)
#pragma unroll
        for (int e = 0; e < 4; ++e) lg[4 * m + e] = p.in[24][4 * lane + 256 * m + e];
    uint4 yt[12];
    { const int tok0 = blockIdx.x * 64;
#pragma unroll
      for (int i = 0; i < 12; ++i) { const int idx = tid + 512 * i, c = idx >> 3, seg = idx & 7; yt[i] = (blockIdx.x < NTOK / 64) ? ldnt4(YHT + (size_t)c * NTOK + tok0 + seg * 8) : make_uint4(0u, 0u, 0u, 0u); } }
    for (int tile = blockIdx.x; tile < NTOK / 64; tile += gridDim.x) {
        const int tok0 = tile * 64;
        __syncthreads();
#pragma unroll
        for (int i = 0; i < 12; ++i) { const int idx = tid + 512 * i, c = idx >> 3, seg = idx & 7; unsigned* d = T + c * 33 + seg * 4; d[0] = yt[i].x; d[1] = yt[i].y; d[2] = yt[i].z; d[3] = yt[i].w; }
        __syncthreads();
        { const int ntile = tile + gridDim.x; const int tokn = (ntile < NTOK / 64 ? ntile : tile) * 64;
#pragma unroll
          for (int i = 0; i < 12; ++i) { const int idx = tid + 512 * i, c = idx >> 3, seg = idx & 7; yt[i] = ldnt4(YHT + (size_t)c * NTOK + tokn + seg * 8); } }
        unsigned gh[2][6]; uint2 hf[2][3], hb[2][3], gl[2][3];
#define YC_ISSUE(slot, ii) { const size_t tk = (size_t)tok0 + 8 * wid + (ii); \
            _Pragma("unroll") for (int m = 0; m < 6; ++m) gh[slot][m] = ldnt1(P2 + tk * 2304 + 2 * lane + 128 * m); \
            _Pragma("unroll") for (int m = 0; m < 3; ++m) { const int c = 4 * lane + 256 * m; hf[slot][m] = ldnt2(HF + tk * DH + c); hb[slot][m] = ldnt2(HB + tk * DH + c); gl[slot][m] = ldnt2(P2 + tk * 2304 + 1536 + c); } }
        YC_ISSUE(0, 0)
#pragma unroll
        for (int i = 0; i < 8; ++i) { const int t = 8 * wid + i; const size_t tok = (size_t)tok0 + t; const int cs = i & 1, ns = cs ^ 1;
            if (i < 7) YC_ISSUE(ns, i + 1)
            float y[12]; float ss = 0.f;
#pragma unroll
            for (int m = 0; m < 6; ++m) { const int c = 2 * lane + 128 * m; y[2 * m] = bf2f(Th[c * 66 + t]); y[2 * m + 1] = bf2f(Th[(c + 1) * 66 + t]); ss += y[2 * m] * y[2 * m] + y[2 * m + 1] * y[2 * m + 1]; }
            ss = wave_sum(ss); const float rs = rsqrtf(ss * (1.0f / DH) + 1e-6f);
#pragma unroll
            for (int m = 0; m < 6; ++m) { const int c = 2 * lane + 128 * m; const unsigned gw = gh[cs][m]; const float g0 = bflo(gw), g1 = bfhi(gw);
                const float o0 = y[2 * m] * rs * hg[2 * m] * (g0 * sigm(g0)), o1 = y[2 * m + 1] * rs * hg[2 * m + 1] * (g1 * sigm(g1));
                *(unsigned*)(YC + tok * 1536 + c) = pk(o0, o1); }
            float q[12]; float s2 = 0.f;
#pragma unroll
            for (int m = 0; m < 3; ++m) { const uint2 f = hf[cs][m], bq = hb[cs][m];
                q[4 * m] = bflo(f.x) + bflo(bq.x); q[4 * m + 1] = bfhi(f.x) + bfhi(bq.x); q[4 * m + 2] = bflo(f.y) + bflo(bq.y); q[4 * m + 3] = bfhi(f.y) + bfhi(bq.y);
                s2 += q[4 * m] * q[4 * m] + q[4 * m + 1] * q[4 * m + 1] + q[4 * m + 2] * q[4 * m + 2] + q[4 * m + 3] * q[4 * m + 3]; }
            s2 = wave_sum(s2); const float rs2 = rsqrtf(s2 * (1.0f / DH) + 1e-6f);
#pragma unroll
            for (int m = 0; m < 3; ++m) { const int c = 4 * lane + 256 * m; const uint2 gw = gl[cs][m];
                const float g0 = bflo(gw.x), g1 = bfhi(gw.x), g2 = bflo(gw.y), g3 = bfhi(gw.y);
                uint2 o; o.x = pk(q[4 * m] * rs2 * lg[4 * m] * (g0 * sigm(g0)), q[4 * m + 1] * rs2 * lg[4 * m + 1] * (g1 * sigm(g1)));
                o.y = pk(q[4 * m + 2] * rs2 * lg[4 * m + 2] * (g2 * sigm(g2)), q[4 * m + 3] * rs2 * lg[4 * m + 3] * (g3 * sigm(g3)));
                *(uint2*)(YC + tok * 1536 + DH + c) = o; }
        }
#undef YC_ISSUE
    }
}
__device__ void phase_final(const Params& p) {
    const int tid = threadIdx.x, lane = tid & 63, wid = tid >> 6;
    const float4* g4 = (const float4*)p.in[26]; float4 gv[4];
#pragma unroll
    for (int i = 0; i < 4; ++i) gv[i] = g4[i * 64 + lane];
    for (int row = blockIdx.x * 8 + wid; row < NTOK; row += gridDim.x * 8) {
        float4* src = (float4*)(p.out + (size_t)row * DM);
        float4 v[4]; float ss = 0.f;
#pragma unroll
        for (int i = 0; i < 4; ++i) { v[i] = src[i * 64 + lane]; ss += v[i].x * v[i].x + v[i].y * v[i].y + v[i].z * v[i].z + v[i].w * v[i].w; }
        ss = wave_sum(ss);
        const float rs = rsqrtf(ss * (1.0f / DM) + 1e-6f);
#pragma unroll
        for (int i = 0; i < 4; ++i) src[i * 64 + lane] = make_float4(v[i].x * rs * gv[i].x, v[i].y * rs * gv[i].y, v[i].z * rs * gv[i].z, v[i].w * rs * gv[i].w);
    }
}

#define XB_TMO      128
#define XB_XCNT(j)  (256  + 64 * (j))
#define XB_XSUB(j)  (1280 + 64 * (j))
#define XB_XGEN(j)  (2304 + 64 * (j))
#define XB_TOP      3328
#define XB_TOPGEN   3392
#define XCD_BAR_WORDS 3456
#define XB_SPIN_CAP (1u << 18)
#define LAS __attribute__((address_space(3)))

__device__ __forceinline__ unsigned xb_ld(unsigned* p)              { return __hip_atomic_load(p, __ATOMIC_RELAXED, __HIP_MEMORY_SCOPE_AGENT); }
__device__ __forceinline__ unsigned xb_add(unsigned* p, unsigned v) { return __hip_atomic_fetch_add(p, v, __ATOMIC_RELAXED, __HIP_MEMORY_SCOPE_AGENT); }
__device__ __forceinline__ unsigned xb_xcc_id() { return (unsigned)__builtin_amdgcn_s_getreg((3 << 11) | 20) & 0xFu; }
#define XB_SPIN(cond, bar) do { unsigned _sp = 0; while (cond) { __builtin_amdgcn_s_sleep(1); \
    if ((++_sp & 255u) == 0u) { if (xb_ld(&(bar)[XB_TMO])) break; if (_sp > XB_SPIN_CAP) { atomicAdd(&(bar)[XB_TMO], 1u); break; } } } } while (0)

struct XcdBarrier {
    unsigned* bar; unsigned x;
    volatile LAS unsigned* st;
};

__device__ __forceinline__ XcdBarrier xcd_barrier_post(unsigned* bar, volatile LAS unsigned* st) {
    XcdBarrier b; b.bar = bar; b.x = xb_xcc_id(); b.st = st;
    if (threadIdx.x == 0) (void)xb_add(&bar[XB_XCNT(b.x)], 1u);
    return b;
}
__device__ __forceinline__ void xcd_barrier_complete(unsigned* bar, unsigned x, unsigned& nloc, unsigned& nx) {
    const unsigned G = gridDim.x * gridDim.y * gridDim.z;
    unsigned sum, cnt, mine, sp = 0u;
    for (;;) {
        sum = 0u; cnt = 0u; mine = 0u;
#pragma unroll
        for (unsigned j = 0; j < 16; ++j) { const unsigned c = xb_ld(&bar[XB_XCNT(j)]); sum += c; cnt += (c > 0u) ? 1u : 0u; mine = (j == x) ? c : mine; }
        if (sum == G) break;
        __builtin_amdgcn_s_sleep(1);
        if ((++sp & 255u) == 0u) { if (xb_ld(&bar[XB_TMO])) break; if (sp > XB_SPIN_CAP) { atomicAdd(&bar[XB_TMO], 1u); break; } }
    }
    nloc = mine > 0u ? mine : 1u; nx = cnt > 0u ? cnt : 1u;
}

__device__ __forceinline__ void xcd_barrier(const XcdBarrier& b) {
    asm volatile("s_waitcnt vmcnt(0)" ::: "memory");
    __syncthreads();
    if (threadIdx.x == 0) {
        unsigned* bar = b.bar;
        __builtin_amdgcn_s_waitcnt(0);
        unsigned nloc = b.st[0], nx = b.st[1];
        if (nloc == 0u) { xcd_barrier_complete(bar, b.x, nloc, nx); b.st[0] = nloc; b.st[1] = nx; }
        const unsigned old = xb_add(&bar[XB_XSUB(b.x)], 1u);
        const unsigned gen = old / nloc;
        if (old + 1u == (gen + 1u) * nloc) {
            __builtin_amdgcn_fence(__ATOMIC_RELEASE, "agent");
            asm volatile("s_waitcnt vmcnt(0)" ::: "memory");
            const unsigned og = xb_add(&bar[XB_TOP], 1u);
            const unsigned tg = og / nx;
            if (og + 1u == (tg + 1u) * nx) xb_add(&bar[XB_TOPGEN], 1u);
            else XB_SPIN(xb_ld(&bar[XB_TOPGEN]) == tg, bar);
            __builtin_amdgcn_fence(__ATOMIC_ACQUIRE, "agent");
            xb_add(&bar[XB_XGEN(b.x)], 1u);
            asm volatile("s_waitcnt vmcnt(0)" ::: "memory");
        } else {
            XB_SPIN(xb_ld(&bar[XB_XGEN(b.x)]) == gen, bar);
            __builtin_amdgcn_fence(__ATOMIC_ACQUIRE, "agent");
            asm volatile("s_waitcnt vmcnt(0)" ::: "memory");
        }
    }
    __syncthreads();
}

constexpr int N_PHASES = 5;
__global__ void __launch_bounds__(512) hymba_fwd(Params p) {
    extern __shared__ __attribute__((aligned(16))) unsigned char lds[];
    cg::grid_group grid = cg::this_grid();
#ifndef ONLY_PHASE
#define ONLY_PHASE -1
#endif
#define PH_ON(n) (ONLY_PHASE < 0 || ONLY_PHASE == (n))
#ifndef DUP_SKIP
#define DUP_SKIP 0
#endif
#ifndef DUP_PHASE
#define DUP_PHASE -1
#endif
    const int lo = p.ph_lo, hi = p.ph_hi;
    volatile LAS unsigned* xst = (volatile LAS unsigned*)((LAS unsigned char*)lds + (LDS_BYTES - 32));
    if (threadIdx.x == 0) { xst[0] = 0u; xst[1] = 0u; }
    __syncthreads();
    const XcdBarrier xb = xcd_barrier_post((unsigned*)(p.ws + OFF_XBAR), xst);
    if (hi > 1000) grid.sync();
    if (lo <= 0 && 0 < hi) { if (PH_ON(0)) phase0(p, lds); if (DUP_PHASE == 0) { grid.sync(); phase0(p, lds); } }
    if (lo <= 1 && 1 < hi) { if (lo < 1) xcd_barrier(xb); if (PH_ON(1)) phase_gemm1(p, lds); if (DUP_PHASE == 1) { grid.sync(); phase_gemm1(p, lds); } }
    if (lo <= 2 && 2 < hi) { if (lo < 2) xcd_barrier(xb); if (PH_ON(2)) phase_mix(p, lds, 0, MIX_SEL); if (DUP_PHASE == 2) { grid.sync(); phase_mix(p, lds, 1, DUP_SKIP); } }
    if (lo <= 3 && 3 < hi) { if (lo < 3) xcd_barrier(xb); if (PH_ON(3)) phase_ycat(p, lds); if (DUP_PHASE == 3) { grid.sync(); phase_ycat(p, lds); } }
    if (lo <= 4 && 4 < hi) { if (lo < 4) xcd_barrier(xb); if (PH_ON(4)) phase_gemm2(p, lds); if (DUP_PHASE == 4) { grid.sync(); phase_gemm2(p, lds); } }
}
extern "C" void kernel_launch(void* const* d_in, const int* in_sizes, int n_in, void* d_out, int out_size, void* d_ws, size_t ws_size, hipStream_t stream) {
    static int grid = 0;
    if (grid == 0) {
        if (n_in != 27 || ws_size < WS_END) { fprintf(stderr, "kernel_launch: expected 27 inputs and >= %zu bytes of workspace (got %d, %zu)\n", (size_t)WS_END, n_in, ws_size); grid = -1; return; }
        int dev = 0, cus = 0, per_cu = 0;
        hipGetDevice(&dev); hipDeviceGetAttribute(&cus, hipDeviceAttributeMultiprocessorCount, dev);
        if (hipFuncSetAttribute((const void*)hymba_fwd, hipFuncAttributeMaxDynamicSharedMemorySize, LDS_BYTES) != hipSuccess) { fprintf(stderr, "kernel_launch: hipFuncSetAttribute failed\n"); grid = -1; return; }
        if (hipOccupancyMaxActiveBlocksPerMultiprocessor(&per_cu, (const void*)hymba_fwd, 512, LDS_BYTES) != hipSuccess || per_cu < 1) { fprintf(stderr, "kernel_launch: occupancy query failed (%d)\n", per_cu); (void)hipGetLastError(); grid = -1; return; }
        grid = cus * per_cu; if (grid > 256) grid = 256; grid &= ~3;
    }
    if (grid < 0) return;
    hipMemsetAsync((char*)d_ws + OFF_CTL, 0, 32768, stream);
    Params p{};
    for (int i = 0; i < 27; ++i) p.in[i] = (const float*)d_in[i];
    p.out = (float*)d_out; p.ws = (unsigned char*)d_ws;
    const int per = (N_PHASES + MK_N_LAUNCHES - 1) / MK_N_LAUNCHES;
    for (int lo = 0; lo < N_PHASES; lo += per) {
        p.ph_lo = lo; p.ph_hi = lo + per < N_PHASES ? lo + per : N_PHASES;
        void* args[] = {&p};
        const hipError_t e = hipLaunchCooperativeKernel((const void*)hymba_fwd, dim3(grid), dim3(512), args, LDS_BYTES, stream);
        if (e != hipSuccess) { fprintf(stderr, "kernel_launch: cooperative launch failed: %s (grid %d)\n", hipGetErrorString(e), grid); break; }
    }
}
```
